# Optimizing an MI355X kernel written in HIP

```python
import jax, jax.numpy as jnp
from jax import lax
import numpy as np

D_MODEL = 2048
BATCH = 8
SEQ = 2048
DEPTH = 1

HEAD_DIM = 128
N_HEADS_TOTAL = D_MODEL // HEAD_DIM
N_FOX_HEADS = N_HEADS_TOTAL // 2
N_SWA_HEADS = N_HEADS_TOTAL - N_FOX_HEADS
N_SWA_KV_HEADS = max(1, N_SWA_HEADS // 4)
SWA_WINDOW = 128
Q_BLOCK = 128
D_FF = 4 * D_MODEL
ROPE_THETA = 10000.0
NORM_EPS = 1e-6
FOX_W = N_FOX_HEADS * HEAD_DIM
SWA_Q_W = N_SWA_HEADS * HEAD_DIM
SWA_KV_W = N_SWA_KV_HEADS * HEAD_DIM
MIX_W = FOX_W + SWA_Q_W
IN_SPLITS = [FOX_W, FOX_W, FOX_W, N_FOX_HEADS, SWA_Q_W, SWA_KV_W, SWA_KV_W]
IN_PROJ_W = sum(IN_SPLITS)
N_MOD = 6

kernel_name = "hymba_fox_swa_sink_hybrid"


def rmsnorm(x, g):
    xf = x.astype(jnp.float32)
    y = xf * lax.rsqrt(jnp.mean(xf * xf, axis=-1, keepdims=True) + NORM_EPS)
    return (y * g.astype(jnp.float32)).astype(x.dtype)


def rope(x, pos):
    d = x.shape[-1]
    half = d // 2
    inv_freq = 1.0 / (ROPE_THETA ** (jnp.arange(half, dtype=jnp.float32) * (2.0 / d)))
    ang = pos.astype(jnp.float32)[:, None] * inv_freq[None, :]
    cos = jnp.cos(ang)[None, :, None, :]
    sin = jnp.sin(ang)[None, :, None, :]
    xf = x.astype(jnp.float32)
    x1, x2 = xf[..., :half], xf[..., half:]
    out = jnp.concatenate([x1 * cos - x2 * sin, x2 * cos + x1 * sin], axis=-1)
    return out.astype(x.dtype)


def forgetting_attention(q, k, v, log_f):
    B, S, H, d = q.shape
    cum = jnp.cumsum(log_f, axis=1).transpose(0, 2, 1)
    scale = d ** -0.5
    tri = jnp.tril(jnp.ones((Q_BLOCK, Q_BLOCK), dtype=bool))
    outs = []
    for i in range(S // Q_BLOCK):
        q0 = i * Q_BLOCK
        end = q0 + Q_BLOCK
        s = jnp.einsum('bqhd,bkhd->bhqk', q[:, q0:end], k[:, :end],
                       preferred_element_type=jnp.float32) * scale
        s = s + cum[:, :, q0:end, None] - cum[:, :, None, :end]
        mask = jnp.concatenate([jnp.ones((Q_BLOCK, q0), dtype=bool), tri], axis=1)
        s = jnp.where(mask[None, None], s, -jnp.inf)
        p = jax.nn.softmax(s, axis=-1)
        outs.append(jnp.einsum('bhqk,bkhd->bqhd', p.astype(v.dtype), v[:, :end]))
    return jnp.concatenate(outs, axis=1)


def sliding_window_sink_attention(q, k, v, sinks):
    B, S, H, d = q.shape
    KVH = k.shape[2]
    G = H // KVH
    nb = S // Q_BLOCK
    scale = d ** -0.5
    pad = ((0, 0), (Q_BLOCK, 0), (0, 0), (0, 0))
    kp = jnp.pad(k, pad).reshape(B, nb + 1, Q_BLOCK, KVH, d)
    vp = jnp.pad(v, pad).reshape(B, nb + 1, Q_BLOCK, KVH, d)
    kb = jnp.concatenate([kp[:, :-1], kp[:, 1:]], axis=2)
    vb = jnp.concatenate([vp[:, :-1], vp[:, 1:]], axis=2)
    qb = q.reshape(B, nb, Q_BLOCK, KVH, G, d)
    s = jnp.einsum('bnqkgd,bnjkd->bnkgqj', qb, kb,
                   preferred_element_type=jnp.float32) * scale
    qi = jnp.arange(Q_BLOCK)[:, None]
    kj = jnp.arange(2 * Q_BLOCK)[None, :]
    diff = qi + Q_BLOCK - kj
    band = (diff >= 0) & (diff < SWA_WINDOW)
    key_idx = jnp.arange(nb)[:, None] * Q_BLOCK + jnp.arange(2 * Q_BLOCK)[None, :] - Q_BLOCK
    valid = key_idx >= 0
    mask = band[None, :, :] & valid[:, None, :]
    s = jnp.where(mask[None, :, None, None], s, -jnp.inf)
    sink = jnp.broadcast_to(sinks.astype(jnp.float32).reshape(KVH, G)[None, None, :, :, None, None],
                            s.shape[:-1] + (1,))
    p = jax.nn.softmax(jnp.concatenate([s, sink], axis=-1), axis=-1)[..., :-1]
    o = jnp.einsum('bnkgqj,bnjkd->bnqkgd', p.astype(v.dtype), vb)
    return o.reshape(B, S, H, d)


def setup_inputs(seed: int = 0) -> dict:
    key = jax.random.key(seed)
    ks = jax.random.split(key, 16)
    f32 = jnp.float32
    D = D_MODEL
    def nrm(k, shape, s):
        return jax.random.normal(k, shape, f32) * s
    return {
        "x": nrm(ks[0], (BATCH, SEQ, D), 1.0),
        "c": nrm(ks[1], (BATCH, D), 1.0),
        "w_mod": nrm(ks[2], (DEPTH, D, N_MOD * D), D ** -0.5),
        "b_mod": nrm(ks[3], (DEPTH, N_MOD * D), 0.02),
        "g_pre_mix": 1.0 + nrm(ks[4], (DEPTH, D), 0.02),
        "g_post_mix": 1.0 + nrm(ks[5], (DEPTH, D), 0.02),
        "w_in": nrm(ks[6], (DEPTH, D, IN_PROJ_W), D ** -0.5),
        "b_forget": jax.random.uniform(ks[7], (DEPTH, N_FOX_HEADS), f32, 1.0, 5.0),
        "swa_sinks": nrm(ks[8], (DEPTH, N_SWA_HEADS), 0.5),
        "w_out": nrm(ks[9], (DEPTH, MIX_W, D), MIX_W ** -0.5),
        "g_pre_mlp": 1.0 + nrm(ks[10], (DEPTH, D), 0.02),
        "g_post_mlp": 1.0 + nrm(ks[11], (DEPTH, D), 0.02),
        "w_up": nrm(ks[12], (DEPTH, D, D_FF), D ** -0.5),
        "w_down": nrm(ks[13], (DEPTH, D_FF, D), D_FF ** -0.5),
    }


def reference(x, c, w_mod, b_mod, g_pre_mix, g_post_mix, w_in, b_forget, swa_sinks,
              w_out, g_pre_mlp, g_post_mlp, w_up, w_down):
    B, S, D = x.shape
    pos = jnp.arange(S)
    split_idx = np.cumsum(IN_SPLITS)[:-1].tolist()
    cond = jax.nn.silu(c)
    for l in range(DEPTH):
        mod = cond @ w_mod[l] + b_mod[l]
        sh_a, sc_a, gt_a, sh_m, sc_m, gt_m = [m[:, None, :] for m in jnp.split(mod, N_MOD, axis=-1)]

        h = rmsnorm(x, g_pre_mix[l]) * (1.0 + sc_a) + sh_a
        proj = h @ w_in[l]
        fq, fk, fv, fg, sq, sk, sv = jnp.split(proj, split_idx, axis=-1)

        log_f = jax.nn.log_sigmoid(fg.astype(jnp.float32) + b_forget[l].astype(jnp.float32))
        fox = forgetting_attention(fq.reshape(B, S, N_FOX_HEADS, HEAD_DIM),
                                   fk.reshape(B, S, N_FOX_HEADS, HEAD_DIM),
                                   fv.reshape(B, S, N_FOX_HEADS, HEAD_DIM), log_f)

        sq = rope(sq.reshape(B, S, N_SWA_HEADS, HEAD_DIM), pos)
        sk = rope(sk.reshape(B, S, N_SWA_KV_HEADS, HEAD_DIM), pos)
        sv = sv.reshape(B, S, N_SWA_KV_HEADS, HEAD_DIM)
        swa = sliding_window_sink_attention(sq, sk, sv, swa_sinks[l])

        mix = jnp.concatenate([fox.reshape(B, S, FOX_W), swa.reshape(B, S, SWA_Q_W)], axis=-1) @ w_out[l]
        x = x + gt_a * rmsnorm(mix, g_post_mix[l])

        h = rmsnorm(x, g_pre_mlp[l]) * (1.0 + sc_m) + sh_m
        y = jnp.square(jax.nn.relu(h @ w_up[l])) @ w_down[l]
        x = x + gt_m * rmsnorm(y, g_post_mlp[l])
    return x
```

```cpp
#include <hip/hip_runtime.h>
#include <hip/hip_bf16.h>
#include <hip/hip_cooperative_groups.h>
#include <cstdio>
#include <cstdint>
namespace cg = cooperative_groups;
namespace pg8 {
#define PG8_LAS __attribute__((address_space(3)))
typedef unsigned short bf16_t;
typedef short bf16x8 __attribute__((ext_vector_type(8)));
typedef float f32x4 __attribute__((ext_vector_type(4)));
typedef unsigned u32x4 __attribute__((ext_vector_type(4)));
constexpr int BM = 256, BK = 64, HALF = 128, HTB = HALF * BK * 2  , STAGE_BYTES = 8 * HTB, NXCD = 8, WGM = 8;

__host__ __device__ __forceinline__ int lds_byte(int r, int c) { const int st = (r >> 4) * 2 + (c >> 5), rr = r & 15, cc = c & 31, ob = rr * 64 + cc * 2; return st * 1024 + (ob ^ (((ob >> 9) & 1) << 5)); }
__host__ __device__ __forceinline__ void stage_rc(int b, int& R, int& C) { const int st = b / 1024, sb = b % 1024, swz = sb ^ (((sb >> 9) & 1) << 5); R = (st >> 1) * 16 + swz / 64; C = (st & 1) * 32 + (swz % 64) / 2; }
__host__ __device__ __forceinline__ int perm32(int rho) { const int n = rho >> 4, i = rho & 15; return 8 * (i >> 2) + 4 * n + (i & 3); }

struct Unit { int pm, pn; };
struct Gemm { const bf16_t* A; const bf16_t* Bt; int M, N, K; int t0; };

struct StaticOrder {
    int nM, nN, nwg, G, c, wgm, rot;
    __host__ __device__ void init(int M, int N, int G_, int c_, int wgm_ = WGM, int rot_ = 0) { nM = M / BM; nN = N / BM; nwg = nM * nN; G = G_; c = c_; wgm = wgm_; rot = rot_; }
    __host__ __device__ bool next(int i, Unit& u) const {
        const long L = (long)i * G + c; if (L >= nwg) return false;
        int wgid = (int)L; { const int q = nwg / NXCD, r = nwg % NXCD, xcd = wgid % NXCD, off = wgid / NXCD; wgid = (xcd < r ? xcd * (q + 1) : r * (q + 1) + (xcd - r) * q) + off; }
        const int nig = wgm * nN, gid = wgid / nig, fm = gid * wgm, gsz = (nM - fm) < wgm ? (nM - fm) : wgm;
        u.pm = fm + ((wgid % nig) % gsz); u.pn = ((wgid % nig) / gsz + (c % NXCD) * rot) % nN; return true;
    }
    __device__ __forceinline__ void a_ready(const Unit&) const {}
    __device__ __forceinline__ void done(const Unit&) const {}
};

__device__ __forceinline__ unsigned cvt_pk_bf16(float lo, float hi) { unsigned r; asm volatile("v_cvt_pk_bf16_f32 %0, %1, %2" : "=v"(r) : "v"(lo), "v"(hi)); return r; }
typedef unsigned u32x4e __attribute__((ext_vector_type(4)));
struct EpiBf16SS {
    static constexpr bool PERM = true, AFTER_DRAIN = false;
    bf16_t* O; int ldc; float* SS;
    __device__ __forceinline__ void operator()(const f32x4 (&acc)[2][2][4][2], const Unit& u, int wr, int wc, int fr, int fq) const {
        const int row0 = u.pm * BM + wr * 64 + fr, col0 = u.pn * BM + wc * 32 + 8 * fq;
#pragma unroll
        for (int ai = 0; ai < 2; ++ai)
#pragma unroll
            for (int m = 0; m < 4; ++m) { const int row = row0 + ai * HALF + m * 16; bf16_t* rowp = O + (size_t)row * ldc + col0; float s = 0.f;
#pragma unroll
                for (int bj = 0; bj < 2; ++bj) { const f32x4 v0 = acc[ai][bj][m][0], v1 = acc[ai][bj][m][1];
                    s += (v0[0] * v0[0] + v0[1] * v0[1]) + (v0[2] * v0[2] + v0[3] * v0[3]) + (v1[0] * v1[0] + v1[1] * v1[1]) + (v1[2] * v1[2] + v1[3] * v1[3]);
                    u32x4e w; w.x = cvt_pk_bf16(v0[0], v0[1]); w.y = cvt_pk_bf16(v0[2], v0[3]); w.z = cvt_pk_bf16(v1[0], v1[1]); w.w = cvt_pk_bf16(v1[2], v1[3]);
                    *(u32x4e*)(rowp + bj * HALF) = w; }
                s += __shfl_xor(s, 16); s += __shfl_xor(s, 32);
                if (fq == 0) SS[(size_t)row * 32 + u.pn * 4 + wc] = s; }
    }
};
struct EpiRelu2 {
    static constexpr bool PERM = true, AFTER_DRAIN = false;
    bf16_t* O; int ldc;
    __device__ __forceinline__ void operator()(const f32x4 (&acc)[2][2][4][2], const Unit& u, int wr, int wc, int fr, int fq) const {
        const int row0 = u.pm * BM + wr * 64 + fr, col0 = u.pn * BM + wc * 32 + 8 * fq;
#pragma unroll
        for (int ai = 0; ai < 2; ++ai)
#pragma unroll
            for (int m = 0; m < 4; ++m) { bf16_t* rowp = O + (size_t)(row0 + ai * HALF + m * 16) * ldc + col0;
#pragma unroll
                for (int bj = 0; bj < 2; ++bj) { f32x4 v0 = acc[ai][bj][m][0], v1 = acc[ai][bj][m][1];
#pragma unroll
                    for (int i = 0; i < 4; ++i) { const float a = fmaxf(v0[i], 0.f), b = fmaxf(v1[i], 0.f); v0[i] = a * a; v1[i] = b * b; }
                    u32x4e w; w.x = cvt_pk_bf16(v0[0], v0[1]); w.y = cvt_pk_bf16(v0[2], v0[3]); w.z = cvt_pk_bf16(v1[0], v1[1]); w.w = cvt_pk_bf16(v1[2], v1[3]);
                    __builtin_nontemporal_store(w, (u32x4e*)(rowp + bj * HALF)); } }
    }
};
struct EpiInProj {
    static constexpr bool PERM = true, AFTER_DRAIN = false;
    bf16_t *QF, *KF, *VF, *SQ, *SK, *SV; float* LOGF; const float* COS; const float* SIN; const float* bforget;
    __device__ __forceinline__ void operator()(const f32x4 (&acc)[2][2][4][2], const Unit& u, int wr, int wc, int fr, int fq) const {
        const int pn = u.pn, row0 = u.pm * BM + wr * 64 + fr, b = u.pm >> 3, s0 = row0 & 2047;
        if (pn == 18) {
            if (wc == 0 && fq == 0) { const f32x4 b0 = *(const f32x4*)bforget, b1 = *(const f32x4*)(bforget + 4);
#pragma unroll
                for (int ai = 0; ai < 2; ++ai)
#pragma unroll
                    for (int m = 0; m < 4; ++m) { const int row = row0 + ai * HALF + m * 16; f32x4 z0 = acc[ai][0][m][0] + b0, z1 = acc[ai][0][m][1] + b1;
#pragma unroll
                        for (int i = 0; i < 4; ++i) { z0[i] = fminf(z0[i], 0.f) - __logf(1.f + __expf(-fabsf(z0[i]))); z1[i] = fminf(z1[i], 0.f) - __logf(1.f + __expf(-fabsf(z1[i]))); }
                        *(f32x4*)(LOGF + (size_t)row * 8) = z0; *(f32x4*)(LOGF + (size_t)row * 8 + 4) = z1; } }
            return;
        }
        bf16_t* base; int nh = 8, hb; bool rope = false;
        if (pn < 4) { base = QF; hb = 2 * pn; } else if (pn < 8) { base = KF; hb = 2 * (pn - 4); } else if (pn < 12) { base = VF; hb = 2 * (pn - 8); }
        else if (pn < 16) { base = SQ; hb = 2 * (pn - 12); rope = true; } else if (pn == 16) { base = SK; nh = 2; hb = 0; rope = true; } else { base = SV; nh = 2; hb = 0; }
#pragma unroll
        for (int ai = 0; ai < 2; ++ai)
#pragma unroll
            for (int m = 0; m < 4; ++m) { const int s = s0 + ai * HALF + m * 16;
                f32x4 c4 = {1.f, 1.f, 1.f, 1.f}, s4 = {0.f, 0.f, 0.f, 0.f};
                if (rope) { c4 = *(const f32x4*)(COS + (size_t)s * 64 + 16 * wc + 4 * fq); s4 = *(const f32x4*)(SIN + (size_t)s * 64 + 16 * wc + 4 * fq); }
#pragma unroll
                for (int bj = 0; bj < 2; ++bj) { const f32x4 x1 = acc[ai][bj][m][0], x2 = acc[ai][bj][m][1];
                    const f32x4 v0 = x1 * c4 - x2 * s4, v1 = x2 * c4 + x1 * s4;
                    u32x4e w; w.x = cvt_pk_bf16(v0[0], v0[1]); w.y = cvt_pk_bf16(v0[2], v0[3]); w.z = cvt_pk_bf16(v1[0], v1[1]); w.w = cvt_pk_bf16(v1[2], v1[3]);
                    *(u32x4e*)(base + ((size_t)(b * nh + hb + bj) * 2048 + s) * 128 + 32 * wc + 8 * fq) = w; } }
    }
};
template <class Epi, class Sched, bool ALIGN_EPI = false, bool SP2 = false>
__device__ __forceinline__ void gemm_phase(PG8_LAS unsigned char* lds, const Gemm g, const Sched& S, const Epi& E) {
    const int tid = threadIdx.x, wid = __builtin_amdgcn_readfirstlane(tid >> 6), lane = tid & 63, wr = wid >> 2, wc = wid & 3, fr = lane & 15, fq = lane >> 4;
    const int K = g.K, nt = K / BK, t0 = g.t0;
#define PG8_KPOS(j) ((size_t)(((j) + t0 >= nt) ? (j) + t0 - nt : (j) + t0) * kstep)
    unsigned voffA[2], voffB[2];
#pragma unroll
    for (int i = 0; i < 2; ++i) { int R, C; stage_rc(tid * 16 + i * 8192, R, C); const int Rb = Epi::PERM ? ((R & ~31) + perm32(R & 31)) : R;
        voffA[i] = (unsigned)(R * K + C) * 2u; voffB[i] = (unsigned)(Rb * K + C) * 2u; }
    const size_t kstep = (size_t)(BK * 2);
    const size_t hstep = (size_t)HALF * K * 2;
    const size_t tstep = 2 * hstep;
    const unsigned ldsw = (unsigned)wid * 1024u;
    const int aoff = lds_byte(wr * 64 + fr, fq * 8), boff = lds_byte(wc * 32 + fr, fq * 8);
#define PG8_SA(b, h) (((b) * 2 + (h)) * HTB)
#define PG8_SB(b, h) ((4 + (b) * 2 + (h)) * HTB)
#define PG8_STAGE(bufoff, gbase, voff) do { _Pragma("unroll") for (int _i = 0; _i < 2; ++_i) \
        __builtin_amdgcn_global_load_lds((const unsigned*)((const char*)(gbase) + (voff)[_i]), (PG8_LAS unsigned*)(lds + (bufoff) + ldsw + _i * 8192), 16, 0, 0); } while (0)
#define PG8_LDA(dst, b, h) do { _Pragma("unroll") for (int m = 0; m < 4; ++m) _Pragma("unroll") for (int k = 0; k < 2; ++k) dst[m][k] = *(const PG8_LAS bf16x8*)(lds + PG8_SA(b, h) + aoff + m * 2048 + k * 1024); } while (0)
#define PG8_LDB(dst, b, h) do { _Pragma("unroll") for (int n = 0; n < 2; ++n) _Pragma("unroll") for (int k = 0; k < 2; ++k) dst[n][k] = *(const PG8_LAS bf16x8*)(lds + PG8_SB(b, h) + boff + n * 2048 + k * 1024); } while (0)
#define PG8_MMA(ai, bj, At, Bt) do { __builtin_amdgcn_s_setprio(1); _Pragma("unroll") for (int m = 0; m < 4; ++m) _Pragma("unroll") for (int n = 0; n < 2; ++n) _Pragma("unroll") for (int k = 0; k < 2; ++k) \
        acc[ai][bj][m][n] = __builtin_amdgcn_mfma_f32_16x16x32_bf16(Bt[n][k], At[m][k], acc[ai][bj][m][n], 0, 0, 0); __builtin_amdgcn_s_setprio(0); } while (0)
#define PG8_WAIT_V(n) asm volatile("s_waitcnt vmcnt(" #n ")" ::: "memory")
#define PG8_WAIT_L(n) asm volatile("s_waitcnt lgkmcnt(" #n ")" ::: "memory")
#define PG8_BAR __builtin_amdgcn_s_barrier()
#define PG8_SCHED __builtin_amdgcn_sched_barrier(0)
    Unit cur, nxt; int ui = 0;
    if (!S.next(0, cur)) return;
    f32x4 acc[2][2][4][2];
#pragma unroll
    for (int a = 0; a < 2; ++a)
#pragma unroll
        for (int b = 0; b < 2; ++b)
#pragma unroll
            for (int m = 0; m < 4; ++m)
#pragma unroll
                for (int n = 0; n < 2; ++n) acc[a][b][m][n] = (f32x4){0.f, 0.f, 0.f, 0.f};
    bf16x8 At[4][2], B0[2][2], B1[2][2];
    const char* cA = (const char*)g.A + (size_t)cur.pm * tstep; const char* cB = (const char*)g.Bt + (size_t)cur.pn * tstep;
    S.a_ready(cur);
    const char* pA = cA + PG8_KPOS(0); const char* pB = cB + PG8_KPOS(0);
    if constexpr (SP2) {
        PG8_STAGE(PG8_SB(0, 0), pB, voffB); PG8_STAGE(PG8_SB(0, 1), pB + hstep, voffB); PG8_STAGE(PG8_SA(0, 0), pA, voffA); PG8_STAGE(PG8_SA(0, 1), pA + hstep, voffA);
        if (wr == 1) PG8_BAR;
        PG8_WAIT_V(2); PG8_BAR;
        PG8_STAGE(PG8_SB(1, 0), pB + kstep, voffB); PG8_STAGE(PG8_SA(1, 0), pA + kstep, voffA); PG8_STAGE(PG8_SB(1, 1), pB + hstep + kstep, voffB);
        PG8_WAIT_V(6); PG8_BAR;
    } else {
        PG8_STAGE(PG8_SB(0, 0), pB, voffB); PG8_STAGE(PG8_SA(0, 0), pA, voffA); PG8_STAGE(PG8_SB(0, 1), pB + hstep, voffB); PG8_STAGE(PG8_SA(0, 1), pA + hstep, voffA);
        if (wr == 1) PG8_BAR;
        PG8_WAIT_V(4); PG8_BAR;
        PG8_STAGE(PG8_SB(1, 0), pB + kstep, voffB); PG8_STAGE(PG8_SA(1, 0), pA + kstep, voffA); PG8_STAGE(PG8_SB(1, 1), pB + hstep + kstep, voffB);
        PG8_WAIT_V(6); PG8_BAR;
    }
    for (;;) {
        const bool has_next = S.next(ui + 1, nxt);
        const char* nA = has_next ? (const char*)g.A + (size_t)nxt.pm * tstep : cA; const char* nB = has_next ? (const char*)g.Bt + (size_t)nxt.pn * tstep : cB;
        for (int t = 0; t < nt; t += 2) {
            const bool last = (t == nt - 2);
            const char* a1 = cA + PG8_KPOS(t + 1);
            const char* a2 = last ? nA + PG8_KPOS(0) : cA + PG8_KPOS(t + 2); const char* b2 = last ? nB + PG8_KPOS(0) : cB + PG8_KPOS(t + 2);
            const char* a3 = a2 + kstep; const char* b3 = b2 + kstep;
            if (last && has_next) S.a_ready(nxt);
            if constexpr (SP2) {
            PG8_LDB(B0, 0, 0); PG8_LDB(B1, 0, 1); PG8_SCHED; PG8_LDA(At, 0, 0); PG8_STAGE(PG8_SA(1, 1), a1 + hstep, voffA);
            PG8_WAIT_V(8); PG8_WAIT_L(0); PG8_BAR; PG8_MMA(0, 0, At, B0); PG8_MMA(0, 1, At, B1); PG8_BAR; PG8_SCHED;
            PG8_LDA(At, 0, 1); PG8_STAGE(PG8_SB(0, 0), b2, voffB); PG8_STAGE(PG8_SB(0, 1), b2 + hstep, voffB); PG8_STAGE(PG8_SA(0, 0), a2, voffA);
            PG8_WAIT_V(8); PG8_WAIT_L(0); PG8_BAR; PG8_MMA(1, 0, At, B0); PG8_MMA(1, 1, At, B1); PG8_BAR; PG8_SCHED;
            PG8_LDB(B0, 1, 0); PG8_LDB(B1, 1, 1); PG8_SCHED; PG8_LDA(At, 1, 0); PG8_STAGE(PG8_SA(0, 1), a2 + hstep, voffA);
            PG8_WAIT_V(8); PG8_WAIT_L(0); PG8_BAR; PG8_MMA(0, 0, At, B0); PG8_MMA(0, 1, At, B1); PG8_BAR; PG8_SCHED;
            PG8_LDA(At, 1, 1); PG8_STAGE(PG8_SB(1, 0), b3, voffB); PG8_STAGE(PG8_SB(1, 1), b3 + hstep, voffB); PG8_STAGE(PG8_SA(1, 0), a3, voffA);
            PG8_WAIT_V(8); PG8_WAIT_L(0); PG8_BAR; PG8_MMA(1, 0, At, B0); PG8_MMA(1, 1, At, B1); PG8_BAR; PG8_SCHED;
            } else {
            PG8_LDB(B0, 0, 0); PG8_SCHED; PG8_LDA(At, 0, 0); PG8_STAGE(PG8_SA(1, 1), a1 + hstep, voffA);
            PG8_WAIT_L(8); PG8_BAR; PG8_WAIT_L(0); PG8_MMA(0, 0, At, B0); PG8_BAR; PG8_SCHED;
            PG8_LDB(B1, 0, 1); PG8_STAGE(PG8_SB(0, 0), b2, voffB);
            PG8_BAR; PG8_WAIT_L(0); PG8_MMA(0, 1, At, B1); PG8_BAR;
            PG8_LDA(At, 0, 1); PG8_STAGE(PG8_SA(0, 0), a2, voffA);
            PG8_BAR; PG8_WAIT_L(0); PG8_MMA(1, 0, At, B0); PG8_BAR; PG8_SCHED;
            PG8_STAGE(PG8_SB(0, 1), b2 + hstep, voffB);
            PG8_WAIT_V(6); PG8_BAR; PG8_MMA(1, 1, At, B1); PG8_BAR;
            PG8_LDB(B0, 1, 0); PG8_SCHED; PG8_LDA(At, 1, 0); PG8_STAGE(PG8_SA(0, 1), a2 + hstep, voffA);
            PG8_WAIT_L(8); PG8_BAR; PG8_WAIT_L(0); PG8_MMA(0, 0, At, B0); PG8_BAR; PG8_SCHED;
            PG8_LDB(B1, 1, 1); PG8_STAGE(PG8_SB(1, 0), b3, voffB);
            PG8_BAR; PG8_WAIT_L(0); PG8_MMA(0, 1, At, B1); PG8_BAR;
            PG8_LDA(At, 1, 1); PG8_STAGE(PG8_SA(1, 0), a3, voffA);
            PG8_BAR; PG8_WAIT_L(0); PG8_MMA(1, 0, At, B0); PG8_BAR; PG8_SCHED;
            PG8_STAGE(PG8_SB(1, 1), b3 + hstep, voffB);
            PG8_WAIT_V(6); PG8_BAR; PG8_MMA(1, 1, At, B1); PG8_BAR;
            }
        }
        if constexpr (ALIGN_EPI) { if (wr == 0) PG8_BAR; }
        if constexpr (!Epi::AFTER_DRAIN) { E(acc, cur, wr, wc, fr, fq); S.done(cur); }
        if (!has_next) break;
#pragma unroll
        for (int a = 0; a < 2; ++a)
#pragma unroll
            for (int b = 0; b < 2; ++b)
#pragma unroll
                for (int m = 0; m < 4; ++m)
#pragma unroll
                    for (int n = 0; n < 2; ++n) acc[a][b][m][n] = (f32x4){0.f, 0.f, 0.f, 0.f};
        cur = nxt; cA = nA; cB = nB; ++ui;
        if constexpr (ALIGN_EPI) { if (wr == 1) PG8_BAR; }
    }
    PG8_WAIT_V(0);
    if constexpr (!ALIGN_EPI) { if (wr == 0) PG8_BAR; }
    PG8_BAR;
    if constexpr (Epi::AFTER_DRAIN) { E.fused(acc, cur, wr, wc, fr, fq, lds, wid, lane); S.done(cur); }
#undef PG8_KPOS
#undef PG8_SA
#undef PG8_SB
#undef PG8_STAGE
#undef PG8_LDA
#undef PG8_LDB
#undef PG8_MMA
#undef PG8_WAIT_V
#undef PG8_WAIT_L
#undef PG8_BAR
#undef PG8_SCHED
}
}

namespace att {
constexpr int D = 128, OSTR = 2048;
constexpr float SCALE = 0.08838834764831845f;
constexpr float THR = 8.f;
constexpr int NW = 8, QBLK = 32, KVBLK = 64, QB = NW * QBLK;
constexpr int SHM_V = KVBLK * D * 2, SHM_K = KVBLK * D * 2;
constexpr int LDS_BYTES = 2 * SHM_V + 2 * SHM_K + NW * 64 * 4;
constexpr int ATT_BIAS_OFF = LDS_BYTES, ATT_SCAN_OFF = ATT_BIAS_OFF + 2048 * 4, ATT_Q_OFF = ATT_SCAN_OFF + 64, ATT_LDS_TOTAL = ATT_Q_OFF + NW * 8192;
using bf16 = __hip_bfloat16;
typedef short bf16x8 __attribute__((ext_vector_type(8)));
typedef short s16x4 __attribute__((ext_vector_type(4)));
typedef float f32x16 __attribute__((ext_vector_type(16)));
typedef float f32x4 __attribute__((ext_vector_type(4)));
typedef unsigned u32x4 __attribute__((ext_vector_type(4)));
template <class A, class Bt> struct same_t { static constexpr bool v = false; };
template <class A> struct same_t<A, A> { static constexpr bool v = true; };
#define KSWZ(row, colB) ((row) * 256 + ((colB) ^ (((row) & 7) << 4)))
#define SBAR() __builtin_amdgcn_sched_barrier(0)
__device__ __forceinline__ int v_st(int k, int c) { const int kk = (k & ~0xC) | ((k & 4) << 1) | ((k & 8) >> 1); return ((kk >> 3) * 4 + (c >> 5)) * 512 + ((kk & 7) * 32 + (c & 31)) * 2; }
__device__ __forceinline__ int v_rd_base(int lane) { return ((lane & 3) << 3) | (((lane >> 2) & 3) << 6) | (((lane >> 4) & 1) << 5) | (((lane >> 5) & 1) << 8); }
constexpr int v_rd_off(int d0, int ks, int half) { return d0 * 512 + ks * 4096 + half * 2048; }
__device__ __forceinline__ int crow(int r, int hi) { return (r & 3) + 8 * (r >> 2) + 4 * hi; }
__device__ __forceinline__ unsigned cvtpk(float lo, float hi) {
    unsigned r; asm volatile("v_cvt_pk_bf16_f32 %0, %1, %2" : "=v"(r) : "v"(lo), "v"(hi)); return r;
}
__device__ __forceinline__ bf16x8 pack8(f32x4 a, f32x4 b) {
    u32x4 w = {cvtpk(a[0], a[1]), cvtpk(a[2], a[3]), cvtpk(b[0], b[1]), cvtpk(b[2], b[3])};
    return *reinterpret_cast<bf16x8*>(&w);
}
template <class T> __device__ __forceinline__ bf16x8 load8(const T* p) {
    if constexpr (same_t<T, float>::v) { return pack8(*(const f32x4*)p, *(const f32x4*)(p + 4)); }
    else { return *reinterpret_cast<const bf16x8*>(p); }
}
__device__ __forceinline__ void mask_tile(f32x16& p0, f32x16& p1, int dq, unsigned W) {
    const float NEG = -__builtin_inff();
#pragma unroll
    for (int r = 0; r < 16; ++r) {
        const int c = (r & 3) + 8 * (r >> 2);
        if ((unsigned)(dq - c) >= W) p0[r] = NEG;
        if ((unsigned)(dq - c - 32) >= W) p1[r] = NEG;
    }
}
__device__ __forceinline__ void partialSM(f32x16& p0, f32x16& p1, float& m_reg, float& mn, float& alpha) {
    float pmax = p0[0]; for (int r = 1; r < 16; ++r) pmax = fmaxf(pmax, p0[r]); for (int r = 0; r < 16; ++r) pmax = fmaxf(pmax, p1[r]);
    { auto rr = __builtin_amdgcn_permlane32_swap(__float_as_uint(pmax), __float_as_uint(pmax), false, false);
      pmax = fmaxf(__uint_as_float(rr[0]), __uint_as_float(rr[1])); }
    constexpr float C2 = 1.4426950408889634f * SCALE;
    if (__builtin_expect(__all((pmax - m_reg) * SCALE <= THR), 1)) { mn = m_reg; alpha = 1.f; }
    else { mn = fmaxf(m_reg, pmax); alpha = __builtin_amdgcn_exp2f((m_reg - mn) * C2); m_reg = mn; }
    const float mnL = -mn * C2;
    for (int r = 0; r < 16; ++r) p0[r] = fmaf(p0[r], C2, mnL); for (int r = 0; r < 16; ++r) p1[r] = fmaf(p1[r], C2, mnL);
    for (int r = 0; r < 16; ++r) p0[r] = __builtin_amdgcn_exp2f(p0[r]);
}
__device__ __forceinline__ void finishSM(f32x16& p0, f32x16& p1, float alpha, float& l_reg, bf16x8& pa0, bf16x8& pa1, bf16x8& pa2, bf16x8& pa3) {
    for (int r = 0; r < 16; ++r) p1[r] = __builtin_amdgcn_exp2f(p1[r]);
    float ps = 0; for (int r = 0; r < 16; ++r) ps += p0[r]; for (int r = 0; r < 16; ++r) ps += p1[r];
    { auto rr = __builtin_amdgcn_permlane32_swap(__float_as_uint(ps), __float_as_uint(ps), false, false);
      ps = __uint_as_float(rr[0]) + __uint_as_float(rr[1]); }
    l_reg = l_reg * alpha + ps;
#define PK4(P, B_, OUT) do { unsigned a0 = cvtpk(P[B_+0], P[B_+1]), a1 = cvtpk(P[B_+2], P[B_+3]);                          \
        unsigned b0 = cvtpk(P[B_+4], P[B_+5]), b1 = cvtpk(P[B_+6], P[B_+7]);                                             \
        auto r0 = __builtin_amdgcn_permlane32_swap(a0, b0, false, false); auto r1 = __builtin_amdgcn_permlane32_swap(a1, b1, false, false); \
        u32x4 w = {r0[0], r1[0], r0[1], r1[1]}; OUT = *reinterpret_cast<bf16x8*>(&w); } while (0)
    PK4(p0, 0, pa0); PK4(p0, 8, pa1); PK4(p1, 0, pa2); PK4(p1, 8, pa3);
#undef PK4
}
template <int KB, bool SK, bool BIAS>
__device__ __forceinline__ void qkt(f32x16& p0, f32x16& p1, const char* K_lds, int r32, int hi, int qd, bool act, const float* bp) {
    if (SK && !act) { const float NEG = -__builtin_inff();
#pragma unroll
        for (int r = 0; r < 16; ++r) { p0[r] = NEG; p1[r] = NEG; } return; }
    if constexpr (BIAS) {
        const f32x4 a0 = *(const f32x4*)(bp), a1 = *(const f32x4*)(bp + 8), a2 = *(const f32x4*)(bp + 16), a3 = *(const f32x4*)(bp + 24);
        const f32x4 b0 = *(const f32x4*)(bp + 32), b1 = *(const f32x4*)(bp + 40), b2 = *(const f32x4*)(bp + 48), b3 = *(const f32x4*)(bp + 56);
        p0 = (f32x16){a0[0], a0[1], a0[2], a0[3], a1[0], a1[1], a1[2], a1[3], a2[0], a2[1], a2[2], a2[3], a3[0], a3[1], a3[2], a3[3]};
        p1 = (f32x16){b0[0], b0[1], b0[2], b0[3], b1[0], b1[1], b1[2], b1[3], b2[0], b2[1], b2[2], b2[3], b3[0], b3[1], b3[2], b3[3]};
    } else { p0 = f32x16{}; p1 = f32x16{}; }
    const char* kb[4];
#pragma unroll
    for (int dd = 0; dd < 4; ++dd) kb[dd] = K_lds + KB * SHM_K + KSWZ(r32, (dd * 16 + hi * 8) * 2);
#pragma unroll
    for (int d0 = 0; d0 < 8; ++d0) { const char* a = kb[d0 & 3] + (d0 >> 2) * 128;
        bf16x8 b0 = *reinterpret_cast<const bf16x8*>(a);
        bf16x8 b1 = *reinterpret_cast<const bf16x8*>(a + 32 * 256);
        const bf16x8 qv = *reinterpret_cast<const bf16x8*>(a + qd);
        p0 = __builtin_amdgcn_mfma_f32_32x32x16_bf16(b0, qv, p0, 0, 0, 0);
        p1 = __builtin_amdgcn_mfma_f32_32x32x16_bf16(b1, qv, p1, 0, 0, 0); }
}
template <int VB, bool SK>
__device__ __forceinline__ void pv_tile(f32x16* o, int vb0, bf16x8 pa0, bf16x8 pa1, bf16x8 pa2, bf16x8 pa3, bool act) {
    if (SK && !act) return;
#define TRRD(dst, off) asm volatile("ds_read_b64_tr_b16 %0, %1 offset:%2" : "=&v"(dst) : "v"(vb0), "i"(off) : "memory")
#define PV_D0(d0) do { s16x4 l0, l1, l2, l3, h0, h1, h2, h3; constexpr int b_ = VB * SHM_V + v_rd_off(d0, 0, 0);     \
        TRRD(l0, b_); TRRD(h0, b_ + 2048); TRRD(l1, b_ + 4096); TRRD(h1, b_ + 6144); TRRD(l2, b_ + 8192); TRRD(h2, b_ + 10240); TRRD(l3, b_ + 12288); TRRD(h3, b_ + 14336); \
        asm volatile("s_waitcnt lgkmcnt(0)" ::: "memory"); SBAR();                 \
        o[d0] = __builtin_amdgcn_mfma_f32_32x32x16_bf16(pa0, (bf16x8){l0[0], l0[1], l0[2], l0[3], h0[0], h0[1], h0[2], h0[3]}, o[d0], 0, 0, 0);   \
        o[d0] = __builtin_amdgcn_mfma_f32_32x32x16_bf16(pa1, (bf16x8){l1[0], l1[1], l1[2], l1[3], h1[0], h1[1], h1[2], h1[3]}, o[d0], 0, 0, 0);   \
        o[d0] = __builtin_amdgcn_mfma_f32_32x32x16_bf16(pa2, (bf16x8){l2[0], l2[1], l2[2], l2[3], h2[0], h2[1], h2[2], h2[3]}, o[d0], 0, 0, 0);   \
        o[d0] = __builtin_amdgcn_mfma_f32_32x32x16_bf16(pa3, (bf16x8){l3[0], l3[1], l3[2], l3[3], h3[0], h3[1], h3[2], h3[3]}, o[d0], 0, 0, 0); } while (0)
    PV_D0(0); PV_D0(1); PV_D0(2); PV_D0(3);
#undef PV_D0
#undef TRRD
}
template <class TIn, class TOut> struct BlockRef { const TIn* Q; const TIn* K; const TIn* V; TOut* O; int P0; };
template <class TIn> struct Seam {
    bf16x8 qr[8];
    bf16x8 st_v0, st_v1, st_k0, st_k1; f32x4 sf0, sf1, sf2, sf3;
    f32x4 tq[16];
};
__device__ __forceinline__ int swa_jlo(int P0, int W) { const int lowk = P0 - W + 1; return lowk > 0 ? lowk / KVBLK : 0; }
template <int PHS, bool REV> __device__ __forceinline__ int first_tile(int P0, int W, int skv) {
    if (!REV) return swa_jlo(P0, W);
    int jh = (P0 + (PHS ? 2 * QBLK : QB) - 1) / KVBLK + 1; if (jh > skv / KVBLK) jh = skv / KVBLK; return jh - 1; }
#define ROW(p, k0, rr) ((p) + (size_t)((k0) + (rr)) * D + sc)
#define ROWU(p, k0, c32) ((p) + ((size_t)(k0) + (c32)) * D)
#define VMW() asm volatile("s_waitcnt vmcnt(0)" ::: "memory")
#define VMWN(n) asm volatile("s_waitcnt vmcnt(%0)" :: "i"(n) : "memory")
#define SLOAD_H(Kp, Vp, k0) do { S.st_v0 = load8<TIn>(ROWU(Vp, k0, 0) + voff); S.st_v1 = load8<TIn>(ROWU(Vp, k0, 32) + voff);              \
                         S.st_k0 = load8<TIn>(ROWU(Kp, k0, 0) + voff); S.st_k1 = load8<TIn>(ROWU(Kp, k0, 32) + voff); } while (0)
#define SWRITE_HK(bf) do { *(bf16x8*)(K_lds + (bf) * SHM_K + kws) = S.st_k0; *(bf16x8*)(K_lds + (bf) * SHM_K + kws + 32 * 256) = S.st_k1; } while (0)
#define SWRITE_HV(bf) do { *(bf16x8*)(V_lds + (bf) * SHM_V + vst0) = S.st_v0; *(bf16x8*)(V_lds + (bf) * SHM_V + vst1) = S.st_v1; } while (0)
#define SWRITE_H(bf) do { SWRITE_HV(bf); SWRITE_HK(bf); } while (0)
#define SLOAD_F(p, k0) do { S.sf0 = *(const f32x4*)ROW(p, k0, sr); S.sf1 = *(const f32x4*)(ROW(p, k0, sr) + 4);                \
                            S.sf2 = *(const f32x4*)ROW(p, k0, 32 + sr); S.sf3 = *(const f32x4*)(ROW(p, k0, 32 + sr) + 4); } while (0)
#define SWRITE_KF(bf) do { *(bf16x8*)(K_lds + (bf) * SHM_K + kws) = pack8(S.sf0, S.sf1); *(bf16x8*)(K_lds + (bf) * SHM_K + kws + 32 * 256) = pack8(S.sf2, S.sf3); } while (0)
#define SWRITE_VF(bf) do { *(bf16x8*)(V_lds + (bf) * SHM_V + vst0) = pack8(S.sf0, S.sf1); *(bf16x8*)(V_lds + (bf) * SHM_V + vst1) = pack8(S.sf2, S.sf3); } while (0)
template <class TIn, class TOut, int PHS = 0, bool REV = false>
__device__ __forceinline__ void causal_swa_prime(const BlockRef<TIn, TOut>& cur, int skv, int W, char* lds, Seam<TIn>& S) {
    constexpr bool F32 = same_t<TIn, float>::v;
    const int tid = threadIdx.x, wid = __builtin_amdgcn_readfirstlane(tid >> 6), lane = tid & 63, r32 = lane & 31, hi = lane >> 5;
    const int sr = tid >> 4, sc = (tid & 15) * 8, kws = KSWZ(sr, sc * 2); char* K_lds = lds + 2 * SHM_V; const unsigned voff = (unsigned)(sr * D + sc);
    const int kb0 = first_tile<PHS, REV>(cur.P0, W, skv) * KVBLK;
    const int wrow = PHS ? (wid >> 1) * PHS + (wid & 1) * QBLK : wid * QBLK;
    for (int d0 = 0; d0 < 8; ++d0) S.qr[d0] = load8<TIn>(cur.Q + (size_t)(wrow + r32) * D + d0 * 16 + hi * 8);
    if constexpr (F32) { SLOAD_F((const float*)cur.K, kb0); VMW(); SWRITE_KF(0); SBAR(); SLOAD_F((const float*)cur.V, kb0); }
    else { SLOAD_H(cur.K, cur.V, kb0); VMW(); SWRITE_HK(0); }
    __syncthreads();
}
template <class TIn, class TOut, bool SK_, bool BIAS, bool SINK, int PHS = 0, bool REV = false>
__device__ __forceinline__ void causal_swa_block(const BlockRef<TIn, TOut>& cur, const BlockRef<TIn, TOut>& nxt, int skv, int W, char* lds, Seam<TIn>& S, const float* sinkp) {
    constexpr bool F32 = same_t<TIn, float>::v;
    const int tid = threadIdx.x, wid = __builtin_amdgcn_readfirstlane(tid >> 6), lane = tid & 63, r32 = lane & 31, hi = lane >> 5;
    const int j_lo = swa_jlo(cur.P0, W);
    constexpr int QSPAN = PHS ? 2 * QBLK : QB;
    int j_hi = (cur.P0 + QSPAN - 1) / KVBLK + 1; if (j_hi > skv / KVBLK) j_hi = skv / KVBLK;
    const int NT = j_hi - j_lo;
    const int kbn = first_tile<PHS, REV>(nxt.P0, W, skv) * KVBLK;
    const int wrow = PHS ? (wid >> 1) * PHS + (wid & 1) * QBLK : wid * QBLK, wpos = PHS ? (wid & 1) * QBLK : wid * QBLK;
    const float sink_raw = SINK ? sinkp[PHS ? (wid >> 1) : 0] * (1.f / SCALE) : 0.f;
    const int qlo = cur.P0 + wpos, qm = qlo + r32 - 4 * hi;
    char* V_lds = lds; char* K_lds = lds + 2 * SHM_V;
    const int qd0 = ATT_Q_OFF + wid * 8192 - 2 * SHM_V;
    { char* Qw = lds + ATT_Q_OFF + wid * 8192;
#pragma unroll
      for (int d0 = 0; d0 < 8; ++d0) *reinterpret_cast<bf16x8*>(Qw + KSWZ(r32, (d0 * 16 + hi * 8) * 2)) = S.qr[d0]; }
    float* ws = (float*)(lds + 2 * SHM_V + 2 * SHM_K) + wid * 64; float* li_l = ws, * al_l = ws + 32;
    float m_reg = SINK ? sink_raw : -1e30f, l_reg = SINK ? 1.f : 0.f; f32x16 o[4] = {};
    const float* bias_l = (const float*)(lds + ATT_BIAS_OFF) + 4 * hi;
#define BIASP(t) (bias_l + KBASE(t))
    const unsigned voff = (unsigned)((tid >> 4) * D + (tid & 15) * 8);
    const int sr = tid >> 4, sc = (tid & 15) * 8, vst0 = v_st(sr, sc), vst1 = vst0 + 8192, kws = KSWZ(sr, sc * 2);
    const int vb0 = (int)(uintptr_t)V_lds + v_rd_base(lane);
    const TIn* Kh = cur.K; const TIn* Vh = cur.V;
#define RESC(a) do { if (__any((a) < 1.f)) { if (hi == 0) al_l[r32] = (a); asm volatile("s_waitcnt lgkmcnt(0)" ::: "memory");              \
                     for (int d_ = 0; d_ < 4; ++d_) for (int r = 0; r < 16; ++r) o[d_][r] *= al_l[crow(r, hi)]; } } while (0)
#define KBASE(t) ((REV ? j_hi - 1 - (t) : j_lo + (t)) * KVBLK)
#define ACT(t) (KBASE(t) <= qlo + QBLK - 1 && KBASE(t) + KVBLK - 1 >= qlo - W + 1)
#define MASKT(P0_, P1_, t) do { const int kb_ = KBASE(t); if ((!SK || ACT(t)) && (kb_ + KVBLK - 1 > qlo || kb_ <= qlo + QBLK - 1 - W)) mask_tile(P0_, P1_, qm - kb_, (unsigned)W); } while (0)
    constexpr int NQL = F32 ? 16 : 8;
    constexpr bool SK = SK_;
#define SEAM_K0() do { VMWN(NQL); if constexpr (F32) { SWRITE_KF(0); SBAR(); SLOAD_F((const float*)nxt.V, kbn); } else { SWRITE_HK(0); } SBAR(); } while (0)
    f32x16 pA0, pA1, pB0, pB1; float mnA, mnB, alA, alB; bf16x8 pa0, pa1, pa2, pa3;
    if constexpr (F32) { VMW(); SWRITE_VF(0); SBAR(); } else { SWRITE_HV(0); SBAR(); }
    if (NT > 1) { if constexpr (F32) SLOAD_F((const float*)Kh, KBASE(1)); else SLOAD_H(Kh, Vh, KBASE(1)); }
    SBAR(); qkt<0, SK, BIAS>(pA0, pA1, K_lds, r32, hi, qd0, ACT(0), BIASP(0));
    if constexpr (F32) { if (NT > 1) { VMW(); SWRITE_KF(1); SBAR(); SLOAD_F((const float*)Vh, KBASE(1)); } }
    MASKT(pA0, pA1, 0); partialSM(pA0, pA1, m_reg, mnA, alA);
    if (NT > 1) { VMW(); if constexpr (F32) { SWRITE_VF(1); SBAR(); if (NT > 2) SLOAD_F((const float*)Kh, KBASE(2)); } else SWRITE_H(1); }
    __syncthreads();
#define HALF_STEP(PX0, PX1, mnX, alX, PY0, PY1, alY, t, KB, VB, SB) do {                                                      \
        SBAR(); qkt<KB, SK, BIAS>(PX0, PX1, K_lds, r32, hi, (KB ? qd0 - SHM_K : qd0), ACT(t), BIASP(t));                                             \
        finishSM(PY0, PY1, alY, l_reg, pa0, pa1, pa2, pa3); SBAR();                                                           \
        if ((t) + 1 < NT) { if constexpr (F32) { VMW(); SWRITE_KF(SB); SBAR(); SLOAD_F((const float*)Vh, KBASE((t) + 1)); }  \
                            else { SLOAD_H(Kh, Vh, KBASE((t) + 1)); } SBAR(); }                                               \
        pv_tile<VB, SK>(o, vb0, pa0, pa1, pa2, pa3, ACT((t) - 1)); MASKT(PX0, PX1, (t)); partialSM(PX0, PX1, m_reg, mnX, alX);                                        \
        __syncthreads();                                                                                                      \
        if ((t) + 1 < NT) { VMW(); if constexpr (F32) { SWRITE_VF(SB); SBAR(); if ((t) + 2 < NT) SLOAD_F((const float*)Kh, KBASE((t) + 2)); } \
                            else { SWRITE_H(SB); } }                                                                          \
        RESC(alX); __syncthreads(); } while (0)
    for (int t = 1; t + 1 < NT; t += 2) {
        HALF_STEP(pB0, pB1, mnB, alB, pA0, pA1, alA, t, 1, 0, 0);
        HALF_STEP(pA0, pA1, mnA, alA, pB0, pB1, alB, t + 1, 0, 1, 1);
    }
    const bool even = (NT & 1) == 0;
    if (even) { SBAR(); qkt<1, SK, BIAS>(pB0, pB1, K_lds, r32, hi, qd0 - SHM_K, ACT(NT - 1), BIASP(NT - 1)); SBAR(); }
#define QROW(e) (nxt.Q + (size_t)(wid * QBLK + r32) * D + ((e) >> 1) * 16 + hi * 8 + ((e) & 1) * 4)
    if constexpr (F32) { SLOAD_F((const float*)nxt.K, kbn); SBAR();
#pragma unroll
        for (int e = 0; e < 8; ++e) S.tq[e] = *(const f32x4*)QROW(e); }
    else { SLOAD_H(nxt.K, nxt.V, kbn); SBAR();
#pragma unroll
        for (int d0 = 0; d0 < 8; ++d0) S.qr[d0] = load8<TIn>(nxt.Q + (size_t)(wrow + r32) * D + d0 * 16 + hi * 8); }
    SBAR();
    finishSM(pA0, pA1, alA, l_reg, pa0, pa1, pa2, pa3); SBAR();
    if constexpr (F32) {
#pragma unroll
        for (int e = 8; e < 16; ++e) S.tq[e] = *(const f32x4*)QROW(e); SBAR(); }
#undef QROW
    pv_tile<0, SK>(o, vb0, pa0, pa1, pa2, pa3, ACT(even ? NT - 2 : NT - 1));
    if (even) { MASKT(pB0, pB1, NT - 1); partialSM(pB0, pB1, m_reg, mnB, alB); __syncthreads(); RESC(alB);
        finishSM(pB0, pB1, alB, l_reg, pa0, pa1, pa2, pa3); SBAR(); pv_tile<1, SK>(o, vb0, pa0, pa1, pa2, pa3, ACT(NT - 1)); }
    SBAR(); SEAM_K0();
    if (hi == 0) li_l[r32] = l_reg; asm volatile("s_waitcnt lgkmcnt(0)" ::: "memory");
    float rli[16];
#pragma unroll
    for (int r = 0; r < 16; ++r) rli[r] = __builtin_amdgcn_rcpf(li_l[crow(r, hi)]);
    TOut* Ow = cur.O + (size_t)wpos * OSTR + (PHS ? (wid >> 1) * D : 0);
#pragma unroll
    for (int r = 0; r < 16; ++r) { const int orow = crow(r, hi);
#pragma unroll
        for (int d0 = 0; d0 < 4; ++d0) { const float v = o[d0][r] * rli[r];
            if constexpr (same_t<TOut, float>::v) { Ow[(size_t)orow * OSTR + d0 * 32 + r32] = v; }
            else { const float vn = __shfl_xor(v, 1);
                   if ((r32 & 1) == 0) *(unsigned*)(Ow + (size_t)orow * OSTR + d0 * 32 + r32) = cvtpk(v, vn); } } }
    if constexpr (F32) {
#pragma unroll
        for (int d0 = 0; d0 < 8; ++d0) S.qr[d0] = pack8(S.tq[2 * d0], S.tq[2 * d0 + 1]); }
    __syncthreads();
#undef RESC
#undef KBASE
#undef BIASP
#undef ACT
#undef MASKT
#undef SEAM_K0
#undef HALF_STEP
}
#undef ROW
#undef VMW
#undef VMWN
#undef SLOAD_H
#undef SWRITE_HK
#undef SWRITE_HV
#undef SWRITE_H
#undef SLOAD_F
#undef SWRITE_KF
#undef SWRITE_VF
#undef KSWZ
#undef SBAR
}
#define LAS __attribute__((address_space(3)))
typedef unsigned short bf16r;
typedef float f32x4 __attribute__((ext_vector_type(4)));
typedef unsigned v4u __attribute__((ext_vector_type(4)));
typedef unsigned v2u __attribute__((ext_vector_type(2)));
constexpr int NWAVES = 8, NTHR = 512;
constexpr int BATCH = 8, SEQ = 2048, DM = 2048, M = BATCH * SEQ, DFF = 8192, NIN = 4616, NINP = 4864, NMOD = 6 * DM;
constexpr float EPS = 1e-6f;
constexpr int KS = 16;
#ifndef MK_N_LAUNCHES
#define MK_N_LAUNCHES 1
#endif
constexpr int N_PHASES = 9;
constexpr size_t MiB = 1u << 20;
constexpr size_t WS_WIN = 1 * MiB, WS_WOUT = 20 * MiB, WS_WUP = 28 * MiB, WS_WDN = 60 * MiB;
constexpr size_t WS_MODP = 92 * MiB, WS_MODF = 98 * MiB, WS_COS = 99 * MiB, WS_SIN = 99 * MiB + 512 * 1024, WS_LOGF = 100 * MiB, WS_SS1 = 101 * MiB, WS_SS2 = 103 * MiB;
constexpr size_t WS_QF = 128 * MiB, WS_KF = 160 * MiB, WS_VF = 192 * MiB, WS_SQ = 224 * MiB, WS_SK = 256 * MiB, WS_SV = 264 * MiB, WS_ATT = 272 * MiB;
constexpr size_t WS_MIX = 128 * MiB;
constexpr size_t WS_U = 128 * MiB;
constexpr size_t WS_XN = 384 * MiB, WS_Y = 384 * MiB;
constexpr size_t WS_X1B = 448 * MiB;
constexpr size_t WS_END = 512 * MiB;
constexpr int LDS_BYTES = 147456;

__device__ __forceinline__ float wave_sum(float v) {
#pragma unroll
    for (int o = 1; o < 64; o <<= 1) v += __shfl_xor(v, o);
    return v;
}
__device__ __forceinline__ unsigned pk2(float lo, float hi) { return pg8::cvt_pk_bf16(lo, hi); }
__device__ __forceinline__ float bflo(unsigned u) { return __uint_as_float(u << 16); }
__device__ __forceinline__ float bfhi(unsigned u) { return __uint_as_float(u & 0xffff0000u); }

__device__ __forceinline__ int rope_dim(int p) { return 4 * (p >> 3) + (p & 3) + 64 * ((p >> 2) & 1); }
template <int MAP> __device__ __forceinline__ int srccol(int n) {
    if (MAP == 0) return n;
    if (n < 3072) return n;
    if (n < 4096) { const int r = n - 3072; return 3080 + (r & ~127) + rope_dim(r & 127); }
    if (n < 4352) { const int r = n - 4096; return 4104 + (r & ~127) + rope_dim(r & 127); }
    if (n < 4608) return 4360 + (n - 4352);
    if (n < 4616) return 3072 + (n - 4608);
    return -1;
}
template <int MAP, bool NTS = false> __device__ __forceinline__ void transpose_item(const float* W, int K, int Nsrc, int nblk, bf16r* WT, LAS float* scr, int item, int lane) {
    const int kb = item / nblk, nb = item % nblk, k0 = 64 * kb, n0 = 32 * nb;
    const int sc = srccol<MAP>(n0 + (lane & 31));
    float tv[32];
#pragma unroll
    for (int i = 0; i < 32; ++i) { const int kk = 2 * i + (lane >> 5); tv[i] = sc >= 0 ? __builtin_nontemporal_load(&W[(size_t)(k0 + kk) * Nsrc + sc]) : 0.f; }
#pragma unroll
    for (int i = 0; i < 32; ++i) { const int kk = 2 * i + (lane >> 5); scr[kk * 33 + (lane & 31)] = tv[i]; }
    asm volatile("s_waitcnt lgkmcnt(0)" ::: "memory");
    const int c = lane & 7;
#pragma unroll
    for (int j = 0; j < 4; ++j) { const int n = (lane >> 3) + 8 * j; const LAS float* s = scr + (8 * c) * 33 + n;
        v4u o; o.x = pk2(s[0 * 33], s[1 * 33]); o.y = pk2(s[2 * 33], s[3 * 33]); o.z = pk2(s[4 * 33], s[5 * 33]); o.w = pk2(s[6 * 33], s[7 * 33]);
        if (NTS) __builtin_nontemporal_store(o, (v4u*)(WT + (size_t)(n0 + n) * K + k0 + 8 * c)); else *(v4u*)(WT + (size_t)(n0 + n) * K + k0 + 8 * c) = o; }
    asm volatile("s_waitcnt lgkmcnt(0)" ::: "memory");
}

#define XB_TMO      128
#define XB_XCNT(j)  (256  + 64 * (j))
#define XB_XSUB(j)  (1280 + 64 * (j))
#define XB_XGEN(j)  (2304 + 64 * (j))
#define XB_TOP      3328
#define XB_TOPGEN   3392
#define XCD_BAR_WORDS 3456
#define XB_SPIN_CAP (1u << 18)

__device__ __forceinline__ unsigned xb_ld(unsigned* p)              { return __hip_atomic_load(p, __ATOMIC_RELAXED, __HIP_MEMORY_SCOPE_AGENT); }
__device__ __forceinline__ unsigned xb_add(unsigned* p, unsigned v) { return __hip_atomic_fetch_add(p, v, __ATOMIC_RELAXED, __HIP_MEMORY_SCOPE_AGENT); }
__device__ __forceinline__ unsigned xb_xcc_id() { return (unsigned)__builtin_amdgcn_s_getreg((3 << 11) | 20) & 0xFu; }
#define XB_SPIN(cond, bar) do { unsigned _sp = 0; while (cond) { __builtin_amdgcn_s_sleep(1); \
    if ((++_sp & 255u) == 0u) { if (xb_ld(&(bar)[XB_TMO])) break; if (_sp > XB_SPIN_CAP) { atomicAdd(&(bar)[XB_TMO], 1u); break; } } } } while (0)

struct XcdBarrier {
    unsigned* bar; unsigned x;
    volatile LAS unsigned* st;
};

__device__ __forceinline__ XcdBarrier xcd_barrier_post(unsigned* bar, volatile LAS unsigned* st) {
    XcdBarrier b; b.bar = bar; b.x = xb_xcc_id(); b.st = st;
    if (threadIdx.x == 0) (void)xb_add(&bar[XB_XCNT(b.x)], 1u);
    return b;
}
__device__ __forceinline__ void xcd_barrier_complete(unsigned* bar, unsigned x, unsigned& nloc, unsigned& nx) {
    const unsigned G = gridDim.x * gridDim.y * gridDim.z;
    unsigned sum, cnt, mine, sp = 0u;
    for (;;) {
        sum = 0u; cnt = 0u; mine = 0u;
#pragma unroll
        for (unsigned j = 0; j < 16; ++j) { const unsigned c = xb_ld(&bar[XB_XCNT(j)]); sum += c; cnt += (c > 0u) ? 1u : 0u; mine = (j == x) ? c : mine; }
        if (sum == G) break;
        __builtin_amdgcn_s_sleep(1);
        if ((++sp & 255u) == 0u) { if (xb_ld(&bar[XB_TMO])) break; if (sp > XB_SPIN_CAP) { atomicAdd(&bar[XB_TMO], 1u); break; } }
    }
    nloc = mine > 0u ? mine : 1u; nx = cnt > 0u ? cnt : 1u;
}

__device__ __forceinline__ void xcd_barrier(const XcdBarrier& b) {
    asm volatile("s_waitcnt vmcnt(0)" ::: "memory");
    __syncthreads();
    if (threadIdx.x == 0) {
        unsigned* bar = b.bar;
        __builtin_amdgcn_s_waitcnt(0);
        unsigned nloc = b.st[0], nx = b.st[1];
        if (nloc == 0u) { xcd_barrier_complete(bar, b.x, nloc, nx); b.st[0] = nloc; b.st[1] = nx; }
        const unsigned old = xb_add(&bar[XB_XSUB(b.x)], 1u);
        const unsigned gen = old / nloc;
        if (old + 1u == (gen + 1u) * nloc) {
            __builtin_amdgcn_fence(__ATOMIC_RELEASE, "agent");
            asm volatile("s_waitcnt vmcnt(0)" ::: "memory");
            const unsigned og = xb_add(&bar[XB_TOP], 1u);
            const unsigned tg = og / nx;
            if (og + 1u == (tg + 1u) * nx) xb_add(&bar[XB_TOPGEN], 1u);
            else XB_SPIN(xb_ld(&bar[XB_TOPGEN]) == tg, bar);
            __builtin_amdgcn_fence(__ATOMIC_ACQUIRE, "agent");
            xb_add(&bar[XB_XGEN(b.x)], 1u);
            asm volatile("s_waitcnt vmcnt(0)" ::: "memory");
        } else {
            XB_SPIN(xb_ld(&bar[XB_XGEN(b.x)]) == gen, bar);
            __builtin_amdgcn_fence(__ATOMIC_ACQUIRE, "agent");
            asm volatile("s_waitcnt vmcnt(0)" ::: "memory");
        }
    }
    __syncthreads();
}

constexpr int LDS_MISC_OFF = 147456 - 128;
struct Args { const float* in[14]; float* out; unsigned char* ws; int ph_lo, ph_hi; };

__global__ void __launch_bounds__(NTHR, 2) fwd_mega(Args a) {
    extern __shared__ __attribute__((aligned(16))) unsigned char lds[];
    LAS unsigned char* lds3 = (LAS unsigned char*)lds;
    const int tid = threadIdx.x, lane = tid & 63, wid = __builtin_amdgcn_readfirstlane(tid >> 6);
    const int G = gridDim.x, bx = blockIdx.x, vcu = (G % 8 == 0) ? (bx % 8) * (G / 8) + bx / 8 : bx;
    const float *x = a.in[0], *cin = a.in[1], *w_mod = a.in[2], *b_mod = a.in[3], *g_pre_mix = a.in[4], *g_post_mix = a.in[5], *w_in = a.in[6], *b_forget = a.in[7],
                *swa_sinks = a.in[8], *w_out = a.in[9], *g_pre_mlp = a.in[10], *g_post_mlp = a.in[11], *w_up = a.in[12], *w_down = a.in[13];
    float* out = a.out; unsigned char* ws = a.ws;
    bf16r *WIN_T = (bf16r*)(ws + WS_WIN), *WOUT_T = (bf16r*)(ws + WS_WOUT), *WUP_T = (bf16r*)(ws + WS_WUP), *WDN_T = (bf16r*)(ws + WS_WDN);
    float *MODP = (float*)(ws + WS_MODP), *MODF = (float*)(ws + WS_MODF), *COS = (float*)(ws + WS_COS), *SIN = (float*)(ws + WS_SIN), *LOGF = (float*)(ws + WS_LOGF),
          *SS1 = (float*)(ws + WS_SS1), *SS2 = (float*)(ws + WS_SS2);
    bf16r *QF = (bf16r*)(ws + WS_QF), *KF = (bf16r*)(ws + WS_KF), *VF = (bf16r*)(ws + WS_VF), *SQ = (bf16r*)(ws + WS_SQ), *SKb = (bf16r*)(ws + WS_SK), *SVb = (bf16r*)(ws + WS_SV),
          *ATT = (bf16r*)(ws + WS_ATT), *MIX = (bf16r*)(ws + WS_MIX), *U = (bf16r*)(ws + WS_U), *XN = (bf16r*)(ws + WS_XN), *Y = (bf16r*)(ws + WS_Y), *X1B = (bf16r*)(ws + WS_X1B);
    const int lo = a.ph_lo, hi = a.ph_hi;
#ifndef PH_MASK
#define PH_MASK 0x1ff
#endif
#define IN(k) (((PH_MASK >> (k)) & 1) && lo <= (k) && (k) < hi)
#define SEAM(k) do { if (IN(k) && IN((k) + 1)) xcd_barrier(bar); } while (0)
    if (lo < 0) cg::this_grid().sync();
    volatile LAS unsigned* MISC = (volatile LAS unsigned*)(lds3 + LDS_MISC_OFF);
    if (tid < 32) MISC[tid] = 0u;
    __syncthreads();
    XcdBarrier bar = xcd_barrier_post((unsigned*)ws + 1024, MISC + 8);

    if (IN(0)) {
        for (int e = bx * NTHR + tid; e < SEQ * 64; e += G * NTHR) { const int pos = e >> 6, i = e & 63;
            const float inv = exp2f(-(float)i * (13.287712379549449f / 64.f)), ang = (float)pos * inv;
            const double rev = (double)ang * 0.15915494309189535; const float fr = (float)(rev - rint(rev));
            COS[e] = __builtin_amdgcn_cosf(fr); SIN[e] = __builtin_amdgcn_sinf(fr); }
        LAS float* condL = (LAS float*)lds3; LAS float* red = (LAS float*)(lds3 + 65536);
        { float cvv[32];
#pragma unroll
          for (int q = 0; q < 32; ++q) cvv[q] = cin[tid + q * NTHR];
#pragma unroll
          for (int q = 0; q < 32; ++q) { const int i = tid + q * NTHR, b = i >> 11, k = i & 2047; const float cv = cvv[q]; condL[k * 8 + b] = cv / (1.f + __expf(-cv)); } }
        __syncthreads();
        for (int item = bx; item < 48 * KS; item += G) { const int cgp = item % 48, kc = item / 48, col = cgp * 256 + lane * 4, k0 = kc * 128 + wid * 16;
            f32x4 ac[8];
#pragma unroll
            for (int b = 0; b < 8; ++b) ac[b] = (f32x4){0.f, 0.f, 0.f, 0.f};
            f32x4 wv[16];
#pragma unroll
            for (int kk = 0; kk < 16; ++kk) wv[kk] = __builtin_nontemporal_load((const f32x4*)(w_mod + (size_t)(k0 + kk) * NMOD + col));
#pragma unroll
            for (int kk = 0; kk < 16; ++kk) { const f32x4 w = wv[kk];
                const f32x4 c0 = *(const LAS f32x4*)(condL + (k0 + kk) * 8), c1 = *(const LAS f32x4*)(condL + (k0 + kk) * 8 + 4);
                ac[0] += w * c0[0]; ac[1] += w * c0[1]; ac[2] += w * c0[2]; ac[3] += w * c0[3]; ac[4] += w * c1[0]; ac[5] += w * c1[1]; ac[6] += w * c1[2]; ac[7] += w * c1[3]; }
#pragma unroll
            for (int b = 0; b < 8; ++b) *(LAS f32x4*)(red + (wid * 8 + b) * 256 + lane * 4) = ac[b];
            __syncthreads();
            { const int b = tid >> 6, c4 = (tid & 63) * 4; f32x4 s = (f32x4){0.f, 0.f, 0.f, 0.f};
#pragma unroll
              for (int w = 0; w < 8; ++w) s += *(const LAS f32x4*)(red + (w * 8 + b) * 256 + c4);
              *(f32x4*)(MODP + (size_t)(kc * 8 + b) * NMOD + cgp * 256 + c4) = s; }
            __syncthreads();
        }
        LAS float* scr = (LAS float*)(lds3 + 63488 + wid * 8448);
        const int gw = vcu * NWAVES + wid, NGW = G * NWAVES;
        constexpr int I_IN = (DM / 64) * (NINP / 32), I_OUT = (DM / 64) * (DM / 32);
        for (int it = gw; it < I_IN + I_OUT; it += NGW) { int r = it;
            if (r < I_IN) { transpose_item<1>(w_in, DM, NIN, NINP / 32, WIN_T, scr, r, lane); continue; } r -= I_IN;
            transpose_item<0>(w_out, DM, DM, DM / 32, WOUT_T, scr, r, lane); }
        __syncthreads();
    }
    SEAM(0);

    if (IN(1)) {
        for (int i = bx * NTHR + tid; i < BATCH * NMOD; i += G * NTHR) { const int b = i / NMOD, n = i - b * NMOD; float s = b_mod[n];
#pragma unroll
            for (int p = 0; p < KS; ++p) s += MODP[(size_t)(p * 8 + b) * NMOD + n];
            MODF[i] = s; }
        LAS float* gsL = (LAS float*)lds3; LAS float* shL = gsL + DM;
        for (int unit = vcu; unit < M / 64; unit += G) { const int b = unit >> 5;
#pragma unroll
            for (int c = tid; c < DM; c += NTHR) { float sh = b_mod[c], sc = b_mod[DM + c];
#pragma unroll
                for (int p = 0; p < KS; ++p) { sh += MODP[(size_t)(p * 8 + b) * NMOD + c]; sc += MODP[(size_t)(p * 8 + b) * NMOD + DM + c]; }
                gsL[c] = g_pre_mix[c] * (1.f + sc); shL[c] = sh; }
            __syncthreads();
            const size_t row0 = (size_t)unit * 64 + wid * 8;
#define P1_LOAD(v, row) do { const f32x4* xr_ = (const f32x4*)(x + (row) * DM) + lane; _Pragma("unroll") for (int j = 0; j < 8; ++j) v[j] = __builtin_nontemporal_load(&xr_[64 * j]); } while (0)
#define P1_PROC(v, row) do { float ss = 0.f; _Pragma("unroll") for (int j = 0; j < 8; ++j) ss += (v[j][0] * v[j][0] + v[j][1] * v[j][1]) + (v[j][2] * v[j][2] + v[j][3] * v[j][3]); \
                const float rstd = rsqrtf(wave_sum(ss) * (1.f / DM) + EPS); v2u* o8 = (v2u*)(XN + (row) * DM) + lane; \
                _Pragma("unroll") for (int j = 0; j < 8; ++j) { const f32x4 g4 = *(const LAS f32x4*)(gsL + 4 * (64 * j + lane)), s4 = *(const LAS f32x4*)(shL + 4 * (64 * j + lane)); \
                    const f32x4 h = v[j] * rstd * g4 + s4; v2u w; w.x = pk2(h[0], h[1]); w.y = pk2(h[2], h[3]); o8[64 * j] = w; } } while (0)
            { f32x4 va[8], vb[8]; P1_LOAD(va, row0);
#pragma unroll
              for (int i = 0; i < 8; i += 2) { P1_LOAD(vb, row0 + i + 1); P1_PROC(va, row0 + i); if (i + 2 < 8) P1_LOAD(va, row0 + i + 2); P1_PROC(vb, row0 + i + 1); } }
#undef P1_LOAD
#undef P1_PROC
            __syncthreads();
        }
    }
    SEAM(1);

    if (IN(2)) {
        pg8::Gemm g{XN, WIN_T, M, NINP, DM, (bx & 7) * 4}; pg8::StaticOrder S; S.init(M, NINP, G, bx, 4, 2);
        pg8::EpiInProj E{QF, KF, VF, SQ, SKb, SVb, LOGF, COS, SIN, b_forget};
        pg8::gemm_phase<pg8::EpiInProj, pg8::StaticOrder, true, true>(lds3, g, S, E);
        { constexpr int I_UP = (DM / 64) * (DFF / 32), I_DN = (DFF / 64) * (DM / 32);
          constexpr unsigned PER = (unsigned)(I_UP + I_DN) / 8u; const unsigned grp = (unsigned)bx & 7u;
          unsigned* ctr = (unsigned*)ws + 8192 + 64 * grp; LAS float* scr = (LAS float*)(lds3 + wid * 8448);
          for (;;) { unsigned it0 = 0u; if (lane == 0) it0 = __hip_atomic_fetch_add(ctr, 2u, __ATOMIC_RELAXED, __HIP_MEMORY_SCOPE_AGENT);
              it0 = (unsigned)__builtin_amdgcn_readfirstlane((int)it0); if (it0 >= PER) break;
              for (unsigned q = 0; q < 2u; ++q) { const unsigned it = grp * PER + it0 + q;
                  if (it < (unsigned)I_UP) transpose_item<0, true>(w_up, DM, DFF, DFF / 32, WUP_T, scr, (int)it, lane); else transpose_item<0, true>(w_down, DFF, DM, DM / 32, WDN_T, scr, (int)it - I_UP, lane); } } }
    }
    SEAM(2);

    if (IN(3)) {
        typedef att::BlockRef<att::bf16, att::bf16> BR;
        char* ldsg = (char*)lds;
        { const int it = vcu & 255; const int b = it >> 5, j = it & 31, h = j >> 2, y = j & 3;
            { float* biasL = (float*)(ldsg + att::ATT_BIAS_OFF); float* scanL = (float*)(ldsg + att::ATT_SCAN_OFF);
              const float* lf = LOGF + ((size_t)b * SEQ + 4 * tid) * 8 + h;
              const float v0 = lf[0], v1 = lf[8], v2 = lf[16], v3 = lf[24]; const float c0 = v0, c1 = c0 + v1, c2 = c1 + v2, c3 = c2 + v3;
              float T = c3;
#pragma unroll
              for (int o = 1; o < 64; o <<= 1) { const float n = __shfl_up(T, o); if (lane >= o) T += n; }
              if (lane == 63) scanL[wid] = T;
              __syncthreads();
              float woff = 0.f;
              for (int w = 0; w < wid; ++w) woff += scanL[w];
              const float base = woff + (T - c3), k = -1.f / att::SCALE;
              *(f32x4*)(biasL + 4 * tid) = (f32x4){(base + c0) * k, (base + c1) * k, (base + c2) * k, (base + c3) * k};
              __syncthreads(); }
            att::Seam<att::bf16> S;
#ifndef NO_FOX
            { BR r0, r1; const size_t hb = (size_t)(b * 8 + h) * SEQ * 128;
              r0.K = r1.K = (const att::bf16*)KF + hb; r0.V = r1.V = (const att::bf16*)VF + hb;
              r0.Q = (const att::bf16*)QF + hb + (size_t)(y * 256) * 128; r1.Q = (const att::bf16*)QF + hb + (size_t)((7 - y) * 256) * 128;
              r0.O = (att::bf16*)ATT + ((size_t)b * SEQ + y * 256) * DM + h * 128; r1.O = (att::bf16*)ATT + ((size_t)b * SEQ + (7 - y) * 256) * DM + h * 128;
              r0.P0 = y * 256; r1.P0 = (7 - y) * 256;
              att::causal_swa_prime<att::bf16, att::bf16, 0, true>(r0, SEQ, 0x40000000, ldsg, S);
              for (int p = 0; p < 2; ++p) att::causal_swa_block<att::bf16, att::bf16, false, true, false, 0, true>(p ? r1 : r0, r1, SEQ, 0x40000000, ldsg, S, nullptr); }
#endif
#ifndef NO_SWA
            { BR r0, r1; const int kvh = j >> 4, c0 = 2 * (j & 15);
              const size_t hq = (size_t)(b * 8 + 4 * kvh) * SEQ * 128, hk = (size_t)(b * 2 + kvh) * SEQ * 128;
              r0.K = r1.K = (const att::bf16*)SKb + hk; r0.V = r1.V = (const att::bf16*)SVb + hk;
              r0.Q = (const att::bf16*)SQ + hq + (size_t)(c0 * 64) * 128; r1.Q = (const att::bf16*)SQ + hq + (size_t)((c0 + 1) * 64) * 128;
              r0.O = (att::bf16*)ATT + ((size_t)b * SEQ + c0 * 64) * DM + 1024 + 4 * kvh * 128; r1.O = (att::bf16*)ATT + ((size_t)b * SEQ + (c0 + 1) * 64) * DM + 1024 + 4 * kvh * 128;
              r0.P0 = c0 * 64; r1.P0 = (c0 + 1) * 64;
              const float* sinkp = swa_sinks + 4 * kvh;
              att::causal_swa_prime<att::bf16, att::bf16, SEQ>(r0, SEQ, 128, ldsg, S);
              BR cur = r0; for (int p = 0; p < 2; ++p) { att::causal_swa_block<att::bf16, att::bf16, true, false, true, SEQ>(cur, r1, SEQ, 128, ldsg, S, sinkp); cur = r1; } }
#endif
        }
    }
    SEAM(3);

    if (IN(4)) {
        pg8::Gemm g{ATT, WOUT_T, M, DM, DM, (bx & 7) * 4}; pg8::StaticOrder S; S.init(M, DM, G, bx, 4);
        pg8::EpiBf16SS E{MIX, DM, SS1};
        pg8::gemm_phase<pg8::EpiBf16SS, pg8::StaticOrder, true, true>(lds3, g, S, E);
    }
    SEAM(4);

    if (IN(5)) {
        LAS float* AL = (LAS float*)lds3; LAS float* BL = AL + DM; LAS float* CL = BL + DM;
        for (int unit = vcu; unit < M / 64; unit += G) { const int b = unit >> 5; const float* mf = MODF + (size_t)b * NMOD;
#pragma unroll
            for (int c = tid; c < DM; c += NTHR) { AL[c] = mf[2 * DM + c] * g_post_mix[c]; BL[c] = g_pre_mlp[c] * (1.f + mf[4 * DM + c]); CL[c] = mf[3 * DM + c]; }
            __syncthreads();
            const size_t row0 = (size_t)unit * 64 + wid * 8;
#define P5_LOAD(vx, vm, sv, row) do { const f32x4* xr_ = (const f32x4*)(x + (row) * DM) + lane; const v2u* mr_ = (const v2u*)(MIX + (row) * DM) + lane; sv = lane < 32 ? SS1[(row) * 32 + lane] : 0.f; \
                _Pragma("unroll") for (int j = 0; j < 8; ++j) { vx[j] = __builtin_nontemporal_load(&xr_[64 * j]); vm[j] = __builtin_nontemporal_load(&mr_[64 * j]); } } while (0)
#define P5_PROC(vx, vm, sv, row) do { const float rm = rsqrtf(wave_sum(sv) * (1.f / DM) + EPS); v2u* xo = (v2u*)(X1B + (row) * DM) + lane; float ss = 0.f; \
                _Pragma("unroll") for (int j = 0; j < 8; ++j) { const f32x4 a4 = *(const LAS f32x4*)(AL + 4 * (64 * j + lane)); const v2u mw = vm[j]; \
                    const f32x4 mx = {bflo(mw.x), bfhi(mw.x), bflo(mw.y), bfhi(mw.y)}; \
                    vx[j] = vx[j] + a4 * mx * rm; { v2u xw_; xw_.x = pk2(vx[j][0], vx[j][1]); xw_.y = pk2(vx[j][2], vx[j][3]); __builtin_nontemporal_store(xw_, &xo[64 * j]); } ss += (vx[j][0] * vx[j][0] + vx[j][1] * vx[j][1]) + (vx[j][2] * vx[j][2] + vx[j][3] * vx[j][3]); } \
                const float rstd = rsqrtf(wave_sum(ss) * (1.f / DM) + EPS); v2u* o8 = (v2u*)(XN + (row) * DM) + lane; \
                _Pragma("unroll") for (int j = 0; j < 8; ++j) { const f32x4 g4 = *(const LAS f32x4*)(BL + 4 * (64 * j + lane)), s4 = *(const LAS f32x4*)(CL + 4 * (64 * j + lane)); \
                    const f32x4 h = vx[j] * rstd * g4 + s4; v2u w; w.x = pk2(h[0], h[1]); w.y = pk2(h[2], h[3]); o8[64 * j] = w; } } while (0)
            { f32x4 xa[8], xb[8]; v2u ma[8], mb[8]; float sa, sb; P5_LOAD(xa, ma, sa, row0);
#pragma unroll
              for (int i = 0; i < 8; i += 2) { P5_LOAD(xb, mb, sb, row0 + i + 1); P5_PROC(xa, ma, sa, row0 + i); if (i + 2 < 8) P5_LOAD(xa, ma, sa, row0 + i + 2); P5_PROC(xb, mb, sb, row0 + i + 1); } }
#undef P5_LOAD
#undef P5_PROC
            __syncthreads();
        }
    }
    SEAM(5);

    if (IN(6)) {
        pg8::Gemm g{XN, WUP_T, M, DFF, DM, (bx & 7) * 4}; pg8::StaticOrder S; S.init(M, DFF, G, bx, 2, 4);
        pg8::EpiRelu2 E{U, DFF};
        pg8::gemm_phase<pg8::EpiRelu2, pg8::StaticOrder, true, true>(lds3, g, S, E);
    }
    SEAM(6);

    if (IN(7)) {
        pg8::Gemm g{U, WDN_T, M, DM, DFF, (bx & 7) * 16}; pg8::StaticOrder S; S.init(M, DM, G, bx, 4, 1);
        pg8::EpiBf16SS E{Y, DM, SS2};
        pg8::gemm_phase<pg8::EpiBf16SS, pg8::StaticOrder, true, true>(lds3, g, S, E);
    }
    SEAM(7);

    if (IN(8)) {
        LAS float* GL = (LAS float*)lds3;
        for (int unit = vcu; unit < M / 64; unit += G) { const int b = unit >> 5; const float* mf = MODF + (size_t)b * NMOD;
#pragma unroll
            for (int c = tid; c < DM; c += NTHR) GL[c] = mf[5 * DM + c] * g_post_mlp[c];
            __syncthreads();
            const size_t row0 = (size_t)unit * 64 + wid * 8;
#define P8_LOAD(vx, vy, sv, row) do { const v2u* xr_ = (const v2u*)(X1B + (row) * DM) + lane; const v2u* yr_ = (const v2u*)(Y + (row) * DM) + lane; sv = lane < 32 ? SS2[(row) * 32 + lane] : 0.f; \
                _Pragma("unroll") for (int j = 0; j < 8; ++j) { vx[j] = __builtin_nontemporal_load(&xr_[64 * j]); vy[j] = __builtin_nontemporal_load(&yr_[64 * j]); } } while (0)
#define P8_PROC(vx, vy, sv, row) do { const float ry = rsqrtf(wave_sum(sv) * (1.f / DM) + EPS); f32x4* xo = (f32x4*)(out + (row) * DM) + lane; \
                _Pragma("unroll") for (int j = 0; j < 8; ++j) { const f32x4 g4 = *(const LAS f32x4*)(GL + 4 * (64 * j + lane)); const v2u yw = vy[j]; \
                    const f32x4 yv = {bflo(yw.x), bfhi(yw.x), bflo(yw.y), bfhi(yw.y)}; const v2u xw_ = vx[j]; const f32x4 xv_ = {bflo(xw_.x), bfhi(xw_.x), bflo(xw_.y), bfhi(xw_.y)}; __builtin_nontemporal_store(xv_ + g4 * yv * ry, &xo[64 * j]); } } while (0)
            { v2u xa[8], xb[8]; v2u ya[8], yb[8]; float sa, sb; P8_LOAD(xa, ya, sa, row0);
#pragma unroll
              for (int i = 0; i < 8; i += 2) { P8_LOAD(xb, yb, sb, row0 + i + 1); P8_PROC(xa, ya, sa, row0 + i); if (i + 2 < 8) P8_LOAD(xa, ya, sa, row0 + i + 2); P8_PROC(xb, yb, sb, row0 + i + 1); } }
#undef P8_LOAD
#undef P8_PROC
            __syncthreads();
        }
    }
#undef IN
#undef SEAM
}

extern "C" void kernel_launch(void* const* d_in, const int* in_sizes, int n_in, void* d_out, int out_size, void* d_ws, size_t ws_size, hipStream_t stream) {
    static int grid = 0;
    if (grid == 0) {
        if (n_in != 14 || in_sizes[0] != M * DM || out_size != M * DM || ws_size < WS_END) { fprintf(stderr, "kernel_launch: shape/workspace mismatch (n_in %d, in0 %d, out %d, ws %zu)\n", n_in, n_in > 0 ? in_sizes[0] : -1, out_size, ws_size); grid = -1; return; }
        int dev = 0, cus = 0, per_cu = 0;
        (void)hipGetDevice(&dev); (void)hipDeviceGetAttribute(&cus, hipDeviceAttributeMultiprocessorCount, dev);
        if (hipFuncSetAttribute((const void*)fwd_mega, hipFuncAttributeMaxDynamicSharedMemorySize, LDS_BYTES) != hipSuccess) fprintf(stderr, "kernel_launch: hipFuncSetAttribute failed\n");
        if (hipOccupancyMaxActiveBlocksPerMultiprocessor(&per_cu, (const void*)fwd_mega, NTHR, LDS_BYTES) != hipSuccess || per_cu < 1) { fprintf(stderr, "kernel_launch: occupancy query says %d\n", per_cu); per_cu = 1; }
        (void)hipGetLastError();
        (void)cus; grid = 256;
    }
    if (grid < 0) return;
    if (hipMemsetAsync(d_ws, 0, 65536, stream) != hipSuccess) { fprintf(stderr, "kernel_launch: memset failed\n"); return; }
    Args a{};
    for (int i = 0; i < 14; ++i) a.in[i] = (const float*)d_in[i];
    a.out = (float*)d_out; a.ws = (unsigned char*)d_ws;
    if (MK_N_LAUNCHES == 1) {
        a.ph_lo = 0; a.ph_hi = N_PHASES;
        void* args[] = {&a};
        hipError_t e = hipLaunchCooperativeKernel((const void*)fwd_mega, dim3(grid), dim3(NTHR), args, LDS_BYTES, stream);
        if (e != hipSuccess) fprintf(stderr, "kernel_launch: cooperative launch failed: %s (grid %d)\n", hipGetErrorString(e), grid);
    } else {
        for (int p = 0; p < N_PHASES; ++p) { a.ph_lo = p; a.ph_hi = p + 1; hipLaunchKernelGGL(fwd_mega, dim3(grid), dim3(NTHR), LDS_BYTES, stream, a); }
    }
}
```

```cpp
#include <hip/hip_runtime.h>
#include <hip/hip_bf16.h>
#include <hip/hip_cooperative_groups.h>
#include <cstdio>
#include <cstdint>
namespace cg = cooperative_groups;
namespace pg8 {
#define PG8_LAS __attribute__((address_space(3)))
typedef unsigned short bf16_t;
typedef short bf16x8 __attribute__((ext_vector_type(8)));
typedef float f32x4 __attribute__((ext_vector_type(4)));
typedef unsigned u32x4 __attribute__((ext_vector_type(4)));
constexpr int BM = 256, BK = 64, HALF = 128, HTB = HALF * BK * 2  , STAGE_BYTES = 8 * HTB, NXCD = 8, WGM = 8;

__host__ __device__ __forceinline__ int lds_byte(int r, int c) { const int st = (r >> 4) * 2 + (c >> 5), rr = r & 15, cc = c & 31, ob = rr * 64 + cc * 2; return st * 1024 + (ob ^ (((ob >> 9) & 1) << 5)); }
__host__ __device__ __forceinline__ void stage_rc(int b, int& R, int& C) { const int st = b / 1024, sb = b % 1024, swz = sb ^ (((sb >> 9) & 1) << 5); R = (st >> 1) * 16 + swz / 64; C = (st & 1) * 32 + (swz % 64) / 2; }
__host__ __device__ __forceinline__ int perm32(int rho) { const int n = rho >> 4, i = rho & 15; return 8 * (i >> 2) + 4 * n + (i & 3); }

struct Unit { int pm, pn; };
struct Gemm { const bf16_t* A; const bf16_t* Bt; int M, N, K; int t0; };

struct StaticOrder {
    int nM, nN, nwg, G, c, wgm, rot;
    __host__ __device__ void init(int M, int N, int G_, int c_, int wgm_ = WGM, int rot_ = 0) { nM = M / BM; nN = N / BM; nwg = nM * nN; G = G_; c = c_; wgm = wgm_; rot = rot_; }
    __host__ __device__ bool next(int i, Unit& u) const {
        const long L = (long)i * G + c; if (L >= nwg) return false;
        int wgid = (int)L; { const int q = nwg / NXCD, r = nwg % NXCD, xcd = wgid % NXCD, off = wgid / NXCD; wgid = (xcd < r ? xcd * (q + 1) : r * (q + 1) + (xcd - r) * q) + off; }
        const int nig = wgm * nN, gid = wgid / nig, fm = gid * wgm, gsz = (nM - fm) < wgm ? (nM - fm) : wgm;
        u.pm = fm + ((wgid % nig) % gsz); u.pn = ((wgid % nig) / gsz + (c % NXCD) * rot) % nN; return true;
    }
    __device__ __forceinline__ void a_ready(const Unit&) const {}
    __device__ __forceinline__ void done(const Unit&) const {}
};

__device__ __forceinline__ unsigned cvt_pk_bf16(float lo, float hi) { unsigned r; asm volatile("v_cvt_pk_bf16_f32 %0, %1, %2" : "=v"(r) : "v"(lo), "v"(hi)); return r; }
typedef unsigned u32x4e __attribute__((ext_vector_type(4)));
struct EpiBf16SS {
    static constexpr bool PERM = true, AFTER_DRAIN = false;
    bf16_t* O; int ldc; float* SS;
    __device__ __forceinline__ void operator()(const f32x4 (&acc)[2][2][4][2], const Unit& u, int wr, int wc, int fr, int fq) const {
        const int row0 = u.pm * BM + wr * 64 + fr, col0 = u.pn * BM + wc * 32 + 8 * fq;
#pragma unroll
        for (int ai = 0; ai < 2; ++ai)
#pragma unroll
            for (int m = 0; m < 4; ++m) { const int row = row0 + ai * HALF + m * 16; bf16_t* rowp = O + (size_t)row * ldc + col0; float s = 0.f;
#pragma unroll
                for (int bj = 0; bj < 2; ++bj) { const f32x4 v0 = acc[ai][bj][m][0], v1 = acc[ai][bj][m][1];
                    s += (v0[0] * v0[0] + v0[1] * v0[1]) + (v0[2] * v0[2] + v0[3] * v0[3]) + (v1[0] * v1[0] + v1[1] * v1[1]) + (v1[2] * v1[2] + v1[3] * v1[3]);
                    u32x4e w; w.x = cvt_pk_bf16(v0[0], v0[1]); w.y = cvt_pk_bf16(v0[2], v0[3]); w.z = cvt_pk_bf16(v1[0], v1[1]); w.w = cvt_pk_bf16(v1[2], v1[3]);
                    *(u32x4e*)(rowp + bj * HALF) = w; }
                s += __shfl_xor(s, 16); s += __shfl_xor(s, 32);
                if (fq == 0) SS[(size_t)row * 32 + u.pn * 4 + wc] = s; }
    }
};
struct EpiRelu2 {
    static constexpr bool PERM = true, AFTER_DRAIN = false;
    bf16_t* O; int ldc;
    __device__ __forceinline__ void operator()(const f32x4 (&acc)[2][2][4][2], const Unit& u, int wr, int wc, int fr, int fq) const {
        const int row0 = u.pm * BM + wr * 64 + fr, col0 = u.pn * BM + wc * 32 + 8 * fq;
#pragma unroll
        for (int ai = 0; ai < 2; ++ai)
#pragma unroll
            for (int m = 0; m < 4; ++m) { bf16_t* rowp = O + (size_t)(row0 + ai * HALF + m * 16) * ldc + col0;
#pragma unroll
                for (int bj = 0; bj < 2; ++bj) { f32x4 v0 = acc[ai][bj][m][0], v1 = acc[ai][bj][m][1];
#pragma unroll
                    for (int i = 0; i < 4; ++i) { const float a = fmaxf(v0[i], 0.f), b = fmaxf(v1[i], 0.f); v0[i] = a * a; v1[i] = b * b; }
                    u32x4e w; w.x = cvt_pk_bf16(v0[0], v0[1]); w.y = cvt_pk_bf16(v0[2], v0[3]); w.z = cvt_pk_bf16(v1[0], v1[1]); w.w = cvt_pk_bf16(v1[2], v1[3]);
                    __builtin_nontemporal_store(w, (u32x4e*)(rowp + bj * HALF)); } }
    }
};
struct EpiInProj {
    static constexpr bool PERM = true, AFTER_DRAIN = false;
    bf16_t *QF, *KF, *VF, *SQ, *SK, *SV; float* LOGF; const float* COS; const float* SIN; const float* bforget;
    __device__ __forceinline__ void operator()(const f32x4 (&acc)[2][2][4][2], const Unit& u, int wr, int wc, int fr, int fq) const {
        const int pn = u.pn, row0 = u.pm * BM + wr * 64 + fr, b = u.pm >> 3, s0 = row0 & 2047;
        if (pn == 18) {
            if (wc == 0 && fq == 0) { const f32x4 b0 = *(const f32x4*)bforget, b1 = *(const f32x4*)(bforget + 4);
#pragma unroll
                for (int ai = 0; ai < 2; ++ai)
#pragma unroll
                    for (int m = 0; m < 4; ++m) { const int row = row0 + ai * HALF + m * 16; f32x4 z0 = acc[ai][0][m][0] + b0, z1 = acc[ai][0][m][1] + b1;
#pragma unroll
                        for (int i = 0; i < 4; ++i) { z0[i] = fminf(z0[i], 0.f) - __logf(1.f + __expf(-fabsf(z0[i]))); z1[i] = fminf(z1[i], 0.f) - __logf(1.f + __expf(-fabsf(z1[i]))); }
                        *(f32x4*)(LOGF + (size_t)row * 8) = z0; *(f32x4*)(LOGF + (size_t)row * 8 + 4) = z1; } }
            return;
        }
        bf16_t* base; int nh = 8, hb; bool rope = false;
        if (pn < 4) { base = QF; hb = 2 * pn; } else if (pn < 8) { base = KF; hb = 2 * (pn - 4); } else if (pn < 12) { base = VF; hb = 2 * (pn - 8); }
        else if (pn < 16) { base = SQ; hb = 2 * (pn - 12); rope = true; } else if (pn == 16) { base = SK; nh = 2; hb = 0; rope = true; } else { base = SV; nh = 2; hb = 0; }
#pragma unroll
        for (int ai = 0; ai < 2; ++ai)
#pragma unroll
            for (int m = 0; m < 4; ++m) { const int s = s0 + ai * HALF + m * 16;
                f32x4 c4 = {1.f, 1.f, 1.f, 1.f}, s4 = {0.f, 0.f, 0.f, 0.f};
                if (rope) { c4 = *(const f32x4*)(COS + (size_t)s * 64 + 16 * wc + 4 * fq); s4 = *(const f32x4*)(SIN + (size_t)s * 64 + 16 * wc + 4 * fq); }
#pragma unroll
                for (int bj = 0; bj < 2; ++bj) { const f32x4 x1 = acc[ai][bj][m][0], x2 = acc[ai][bj][m][1];
                    const f32x4 v0 = x1 * c4 - x2 * s4, v1 = x2 * c4 + x1 * s4;
                    u32x4e w; w.x = cvt_pk_bf16(v0[0], v0[1]); w.y = cvt_pk_bf16(v0[2], v0[3]); w.z = cvt_pk_bf16(v1[0], v1[1]); w.w = cvt_pk_bf16(v1[2], v1[3]);
                    *(u32x4e*)(base + ((size_t)(b * nh + hb + bj) * 2048 + s) * 128 + 32 * wc + 8 * fq) = w; } }
    }
};
template <class Epi, class Sched, bool ALIGN_EPI = false, bool SP2 = false>
__device__ __forceinline__ void gemm_phase(PG8_LAS unsigned char* lds, const Gemm g, const Sched& S, const Epi& E) {
    const int tid = threadIdx.x, wid = __builtin_amdgcn_readfirstlane(tid >> 6), lane = tid & 63, wr = wid >> 2, wc = wid & 3, fr = lane & 15, fq = lane >> 4;
    const int K = g.K, nt = K / BK, t0 = g.t0;
#define PG8_KPOS(j) ((size_t)(((j) + t0 >= nt) ? (j) + t0 - nt : (j) + t0) * kstep)
    unsigned voffA[2], voffB[2];
#pragma unroll
    for (int i = 0; i < 2; ++i) { int R, C; stage_rc(tid * 16 + i * 8192, R, C); const int Rb = Epi::PERM ? ((R & ~31) + perm32(R & 31)) : R;
        voffA[i] = (unsigned)(R * K + C) * 2u; voffB[i] = (unsigned)(Rb * K + C) * 2u; }
    const size_t kstep = (size_t)(BK * 2);
    const size_t hstep = (size_t)HALF * K * 2;
    const size_t tstep = 2 * hstep;
    const unsigned ldsw = (unsigned)wid * 1024u;
    const int aoff = lds_byte(wr * 64 + fr, fq * 8), boff = lds_byte(wc * 32 + fr, fq * 8);
#define PG8_SA(b, h) (((b) * 2 + (h)) * HTB)
#define PG8_SB(b, h) ((4 + (b) * 2 + (h)) * HTB)
#define PG8_STAGE(bufoff, gbase, voff) do { _Pragma("unroll") for (int _i = 0; _i < 2; ++_i) \
        __builtin_amdgcn_global_load_lds((const unsigned*)((const char*)(gbase) + (voff)[_i]), (PG8_LAS unsigned*)(lds + (bufoff) + ldsw + _i * 8192), 16, 0, 0); } while (0)
#define PG8_LDA(dst, b, h) do { _Pragma("unroll") for (int m = 0; m < 4; ++m) _Pragma("unroll") for (int k = 0; k < 2; ++k) dst[m][k] = *(const PG8_LAS bf16x8*)(lds + PG8_SA(b, h) + aoff + m * 2048 + k * 1024); } while (0)
#define PG8_LDB(dst, b, h) do { _Pragma("unroll") for (int n = 0; n < 2; ++n) _Pragma("unroll") for (int k = 0; k < 2; ++k) dst[n][k] = *(const PG8_LAS bf16x8*)(lds + PG8_SB(b, h) + boff + n * 2048 + k * 1024); } while (0)
#define PG8_MMA(ai, bj, At, Bt) do { __builtin_amdgcn_s_setprio(1); _Pragma("unroll") for (int m = 0; m < 4; ++m) _Pragma("unroll") for (int n = 0; n < 2; ++n) _Pragma("unroll") for (int k = 0; k < 2; ++k) \
        acc[ai][bj][m][n] = __builtin_amdgcn_mfma_f32_16x16x32_bf16(Bt[n][k], At[m][k], acc[ai][bj][m][n], 0, 0, 0); __builtin_amdgcn_s_setprio(0); } while (0)
#define PG8_WAIT_V(n) asm volatile("s_waitcnt vmcnt(" #n ")" ::: "memory")
#define PG8_WAIT_L(n) asm volatile("s_waitcnt lgkmcnt(" #n ")" ::: "memory")
#define PG8_BAR __builtin_amdgcn_s_barrier()
#define PG8_SCHED __builtin_amdgcn_sched_barrier(0)
    Unit cur, nxt; int ui = 0;
    if (!S.next(0, cur)) return;
    f32x4 acc[2][2][4][2];
#pragma unroll
    for (int a = 0; a < 2; ++a)
#pragma unroll
        for (int b = 0; b < 2; ++b)
#pragma unroll
            for (int m = 0; m < 4; ++m)
#pragma unroll
                for (int n = 0; n < 2; ++n) acc[a][b][m][n] = (f32x4){0.f, 0.f, 0.f, 0.f};
    bf16x8 At[4][2], B0[2][2], B1[2][2];
    const char* cA = (const char*)g.A + (size_t)cur.pm * tstep; const char* cB = (const char*)g.Bt + (size_t)cur.pn * tstep;
    S.a_ready(cur);
    const char* pA = cA + PG8_KPOS(0); const char* pB = cB + PG8_KPOS(0);
    if constexpr (SP2) {
        PG8_STAGE(PG8_SB(0, 0), pB, voffB); PG8_STAGE(PG8_SB(0, 1), pB + hstep, voffB); PG8_STAGE(PG8_SA(0, 0), pA, voffA); PG8_STAGE(PG8_SA(0, 1), pA + hstep, voffA);
        if (wr == 1) PG8_BAR;
        PG8_WAIT_V(2); PG8_BAR;
        PG8_STAGE(PG8_SB(1, 0), pB + kstep, voffB); PG8_STAGE(PG8_SA(1, 0), pA + kstep, voffA); PG8_STAGE(PG8_SB(1, 1), pB + hstep + kstep, voffB);
        PG8_WAIT_V(6); PG8_BAR;
    } else {
        PG8_STAGE(PG8_SB(0, 0), pB, voffB); PG8_STAGE(PG8_SA(0, 0), pA, voffA); PG8_STAGE(PG8_SB(0, 1), pB + hstep, voffB); PG8_STAGE(PG8_SA(0, 1), pA + hstep, voffA);
        if (wr == 1) PG8_BAR;
        PG8_WAIT_V(4); PG8_BAR;
        PG8_STAGE(PG8_SB(1, 0), pB + kstep, voffB); PG8_STAGE(PG8_SA(1, 0), pA + kstep, voffA); PG8_STAGE(PG8_SB(1, 1), pB + hstep + kstep, voffB);
        PG8_WAIT_V(6); PG8_BAR;
    }
    for (;;) {
        const bool has_next = S.next(ui + 1, nxt);
        const char* nA = has_next ? (const char*)g.A + (size_t)nxt.pm * tstep : cA; const char* nB = has_next ? (const char*)g.Bt + (size_t)nxt.pn * tstep : cB;
        for (int t = 0; t < nt; t += 2) {
            const bool last = (t == nt - 2);
            const char* a1 = cA + PG8_KPOS(t + 1);
            const char* a2 = last ? nA + PG8_KPOS(0) : cA + PG8_KPOS(t + 2); const char* b2 = last ? nB + PG8_KPOS(0) : cB + PG8_KPOS(t + 2);
            const char* a3 = a2 + kstep; const char* b3 = b2 + kstep;
            if (last && has_next) S.a_ready(nxt);
            if constexpr (SP2) {
            PG8_LDB(B0, 0, 0); PG8_LDB(B1, 0, 1); PG8_SCHED; PG8_LDA(At, 0, 0); PG8_STAGE(PG8_SA(1, 1), a1 + hstep, voffA);
            PG8_WAIT_V(8); PG8_WAIT_L(0); PG8_BAR; PG8_MMA(0, 0, At, B0); PG8_MMA(0, 1, At, B1); PG8_BAR; PG8_SCHED;
            PG8_LDA(At, 0, 1); PG8_STAGE(PG8_SB(0, 0), b2, voffB); PG8_STAGE(PG8_SB(0, 1), b2 + hstep, voffB); PG8_STAGE(PG8_SA(0, 0), a2, voffA);
            PG8_WAIT_V(8); PG8_WAIT_L(0); PG8_BAR; PG8_MMA(1, 0, At, B0); PG8_MMA(1, 1, At, B1); PG8_BAR; PG8_SCHED;
            PG8_LDB(B0, 1, 0); PG8_LDB(B1, 1, 1); PG8_SCHED; PG8_LDA(At, 1, 0); PG8_STAGE(PG8_SA(0, 1), a2 + hstep, voffA);
            PG8_WAIT_V(8); PG8_WAIT_L(0); PG8_BAR; PG8_MMA(0, 0, At, B0); PG8_MMA(0, 1, At, B1); PG8_BAR; PG8_SCHED;
            PG8_LDA(At, 1, 1); PG8_STAGE(PG8_SB(1, 0), b3, voffB); PG8_STAGE(PG8_SB(1, 1), b3 + hstep, voffB); PG8_STAGE(PG8_SA(1, 0), a3, voffA);
            PG8_WAIT_V(8); PG8_WAIT_L(0); PG8_BAR; PG8_MMA(1, 0, At, B0); PG8_MMA(1, 1, At, B1); PG8_BAR; PG8_SCHED;
            } else {
            PG8_LDB(B0, 0, 0); PG8_SCHED; PG8_LDA(At, 0, 0); PG8_STAGE(PG8_SA(1, 1), a1 + hstep, voffA);
            PG8_WAIT_L(8); PG8_BAR; PG8_WAIT_L(0); PG8_MMA(0, 0, At, B0); PG8_BAR; PG8_SCHED;
            PG8_LDB(B1, 0, 1); PG8_STAGE(PG8_SB(0, 0), b2, voffB);
            PG8_BAR; PG8_WAIT_L(0); PG8_MMA(0, 1, At, B1); PG8_BAR;
            PG8_LDA(At, 0, 1); PG8_STAGE(PG8_SA(0, 0), a2, voffA);
            PG8_BAR; PG8_WAIT_L(0); PG8_MMA(1, 0, At, B0); PG8_BAR; PG8_SCHED;
            PG8_STAGE(PG8_SB(0, 1), b2 + hstep, voffB);
            PG8_WAIT_V(6); PG8_BAR; PG8_MMA(1, 1, At, B1); PG8_BAR;
            PG8_LDB(B0, 1, 0); PG8_SCHED; PG8_LDA(At, 1, 0); PG8_STAGE(PG8_SA(0, 1), a2 + hstep, voffA);
            PG8_WAIT_L(8); PG8_BAR; PG8_WAIT_L(0); PG8_MMA(0, 0, At, B0); PG8_BAR; PG8_SCHED;
            PG8_LDB(B1, 1, 1); PG8_STAGE(PG8_SB(1, 0), b3, voffB);
            PG8_BAR; PG8_WAIT_L(0); PG8_MMA(0, 1, At, B1); PG8_BAR;
            PG8_LDA(At, 1, 1); PG8_STAGE(PG8_SA(1, 0), a3, voffA);
            PG8_BAR; PG8_WAIT_L(0); PG8_MMA(1, 0, At, B0); PG8_BAR; PG8_SCHED;
            PG8_STAGE(PG8_SB(1, 1), b3 + hstep, voffB);
            PG8_WAIT_V(6); PG8_BAR; PG8_MMA(1, 1, At, B1); PG8_BAR;
            }
        }
        if constexpr (ALIGN_EPI) { if (wr == 0) PG8_BAR; }
        if constexpr (!Epi::AFTER_DRAIN) { E(acc, cur, wr, wc, fr, fq); S.done(cur); }
        if (!has_next) break;
#pragma unroll
        for (int a = 0; a < 2; ++a)
#pragma unroll
            for (int b = 0; b < 2; ++b)
#pragma unroll
                for (int m = 0; m < 4; ++m)
#pragma unroll
                    for (int n = 0; n < 2; ++n) acc[a][b][m][n] = (f32x4){0.f, 0.f, 0.f, 0.f};
        cur = nxt; cA = nA; cB = nB; ++ui;
        if constexpr (ALIGN_EPI) { if (wr == 1) PG8_BAR; }
    }
    PG8_WAIT_V(0);
    if constexpr (!ALIGN_EPI) { if (wr == 0) PG8_BAR; }
    PG8_BAR;
    if constexpr (Epi::AFTER_DRAIN) { E.fused(acc, cur, wr, wc, fr, fq, lds, wid, lane); S.done(cur); }
#undef PG8_KPOS
#undef PG8_SA
#undef PG8_SB
#undef PG8_STAGE
#undef PG8_LDA
#undef PG8_LDB
#undef PG8_MMA
#undef PG8_WAIT_V
#undef PG8_WAIT_L
#undef PG8_BAR
#undef PG8_SCHED
}
}

namespace att {
constexpr int D = 128, OSTR = 2048;
constexpr float SCALE = 0.08838834764831845f;
constexpr float THR = 8.f;
constexpr int NW = 8, QBLK = 32, KVBLK = 64, QB = NW * QBLK;
constexpr int SHM_V = KVBLK * D * 2, SHM_K = KVBLK * D * 2;
constexpr int LDS_BYTES = 2 * SHM_V + 2 * SHM_K + NW * 64 * 4;
constexpr int ATT_BIAS_OFF = LDS_BYTES, ATT_SCAN_OFF = ATT_BIAS_OFF + 2048 * 4, ATT_Q_OFF = ATT_SCAN_OFF + 64, ATT_LDS_TOTAL = ATT_Q_OFF + NW * 8192;
using bf16 = __hip_bfloat16;
typedef short bf16x8 __attribute__((ext_vector_type(8)));
typedef short s16x4 __attribute__((ext_vector_type(4)));
typedef float f32x16 __attribute__((ext_vector_type(16)));
typedef float f32x4 __attribute__((ext_vector_type(4)));
typedef unsigned u32x4 __attribute__((ext_vector_type(4)));
template <class A, class Bt> struct same_t { static constexpr bool v = false; };
template <class A> struct same_t<A, A> { static constexpr bool v = true; };
#define KSWZ(row, colB) ((row) * 256 + ((colB) ^ (((row) & 7) << 4)))
#define SBAR() __builtin_amdgcn_sched_barrier(0)
__device__ __forceinline__ int v_st(int k, int c) { const int kk = (k & ~0xC) | ((k & 4) << 1) | ((k & 8) >> 1); return ((kk >> 3) * 4 + (c >> 5)) * 512 + ((kk & 7) * 32 + (c & 31)) * 2; }
__device__ __forceinline__ int v_rd_base(int lane) { return ((lane & 3) << 3) | (((lane >> 2) & 3) << 6) | (((lane >> 4) & 1) << 5) | (((lane >> 5) & 1) << 8); }
constexpr int v_rd_off(int d0, int ks, int half) { return d0 * 512 + ks * 4096 + half * 2048; }
__device__ __forceinline__ int crow(int r, int hi) { return (r & 3) + 8 * (r >> 2) + 4 * hi; }
__device__ __forceinline__ unsigned cvtpk(float lo, float hi) {
    unsigned r; asm volatile("v_cvt_pk_bf16_f32 %0, %1, %2" : "=v"(r) : "v"(lo), "v"(hi)); return r;
}
__device__ __forceinline__ bf16x8 pack8(f32x4 a, f32x4 b) {
    u32x4 w = {cvtpk(a[0], a[1]), cvtpk(a[2], a[3]), cvtpk(b[0], b[1]), cvtpk(b[2], b[3])};
    return *reinterpret_cast<bf16x8*>(&w);
}
template <class T> __device__ __forceinline__ bf16x8 load8(const T* p) {
    if constexpr (same_t<T, float>::v) { return pack8(*(const f32x4*)p, *(const f32x4*)(p + 4)); }
    else { return *reinterpret_cast<const bf16x8*>(p); }
}
__device__ __forceinline__ void mask_tile(f32x16& p0, f32x16& p1, int dq, unsigned W) {
    const float NEG = -__builtin_inff();
#pragma unroll
    for (int r = 0; r < 16; ++r) {
        const int c = (r & 3) + 8 * (r >> 2);
        if ((unsigned)(dq - c) >= W) p0[r] = NEG;
        if ((unsigned)(dq - c - 32) >= W) p1[r] = NEG;
    }
}
__device__ __forceinline__ void partialSM(f32x16& p0, f32x16& p1, float& m_reg, float& mn, float& alpha) {
    float pmax = p0[0]; for (int r = 1; r < 16; ++r) pmax = fmaxf(pmax, p0[r]); for (int r = 0; r < 16; ++r) pmax = fmaxf(pmax, p1[r]);
    { auto rr = __builtin_amdgcn_permlane32_swap(__float_as_uint(pmax), __float_as_uint(pmax), false, false);
      pmax = fmaxf(__uint_as_float(rr[0]), __uint_as_float(rr[1])); }
    constexpr float C2 = 1.4426950408889634f * SCALE;
    if (__builtin_expect(__all((pmax - m_reg) * SCALE <= THR), 1)) { mn = m_reg; alpha = 1.f; }
    else { mn = fmaxf(m_reg, pmax); alpha = __builtin_amdgcn_exp2f((m_reg - mn) * C2); m_reg = mn; }
    const float mnL = -mn * C2;
    for (int r = 0; r < 16; ++r) p0[r] = fmaf(p0[r], C2, mnL); for (int r = 0; r < 16; ++r) p1[r] = fmaf(p1[r], C2, mnL);
    for (int r = 0; r < 16; ++r) p0[r] = __builtin_amdgcn_exp2f(p0[r]);
}
__device__ __forceinline__ void finishSM(f32x16& p0, f32x16& p1, float alpha, float& l_reg, bf16x8& pa0, bf16x8& pa1, bf16x8& pa2, bf16x8& pa3) {
    for (int r = 0; r < 16; ++r) p1[r] = __builtin_amdgcn_exp2f(p1[r]);
    float ps = 0; for (int r = 0; r < 16; ++r) ps += p0[r]; for (int r = 0; r < 16; ++r) ps += p1[r];
    { auto rr = __builtin_amdgcn_permlane32_swap(__float_as_uint(ps), __float_as_uint(ps), false, false);
      ps = __uint_as_float(rr[0]) + __uint_as_float(rr[1]); }
    l_reg = l_reg * alpha + ps;
#define PK4(P, B_, OUT) do { unsigned a0 = cvtpk(P[B_+0], P[B_+1]), a1 = cvtpk(P[B_+2], P[B_+3]);                          \
        unsigned b0 = cvtpk(P[B_+4], P[B_+5]), b1 = cvtpk(P[B_+6], P[B_+7]);                                             \
        auto r0 = __builtin_amdgcn_permlane32_swap(a0, b0, false, false); auto r1 = __builtin_amdgcn_permlane32_swap(a1, b1, false, false); \
        u32x4 w = {r0[0], r1[0], r0[1], r1[1]}; OUT = *reinterpret_cast<bf16x8*>(&w); } while (0)
    PK4(p0, 0, pa0); PK4(p0, 8, pa1); PK4(p1, 0, pa2); PK4(p1, 8, pa3);
#undef PK4
}
template <int KB, bool SK, bool BIAS>
__device__ __forceinline__ void qkt(f32x16& p0, f32x16& p1, const char* K_lds, int r32, int hi, int qd, bool act, const float* bp) {
    if (SK && !act) { const float NEG = -__builtin_inff();
#pragma unroll
        for (int r = 0; r < 16; ++r) { p0[r] = NEG; p1[r] = NEG; } return; }
    if constexpr (BIAS) {
        const f32x4 a0 = *(const f32x4*)(bp), a1 = *(const f32x4*)(bp + 8), a2 = *(const f32x4*)(bp + 16), a3 = *(const f32x4*)(bp + 24);
        const f32x4 b0 = *(const f32x4*)(bp + 32), b1 = *(const f32x4*)(bp + 40), b2 = *(const f32x4*)(bp + 48), b3 = *(const f32x4*)(bp + 56);
        p0 = (f32x16){a0[0], a0[1], a0[2], a0[3], a1[0], a1[1], a1[2], a1[3], a2[0], a2[1], a2[2], a2[3], a3[0], a3[1], a3[2], a3[3]};
        p1 = (f32x16){b0[0], b0[1], b0[2], b0[3], b1[0], b1[1], b1[2], b1[3], b2[0], b2[1], b2[2], b2[3], b3[0], b3[1], b3[2], b3[3]};
    } else { p0 = f32x16{}; p1 = f32x16{}; }
    const char* kb[4];
#pragma unroll
    for (int dd = 0; dd < 4; ++dd) kb[dd] = K_lds + KB * SHM_K + KSWZ(r32, (dd * 16 + hi * 8) * 2);
#pragma unroll
    for (int d0 = 0; d0 < 8; ++d0) { const char* a = kb[d0 & 3] + (d0 >> 2) * 128;
        bf16x8 b0 = *reinterpret_cast<const bf16x8*>(a);
        bf16x8 b1 = *reinterpret_cast<const bf16x8*>(a + 32 * 256);
        const bf16x8 qv = *reinterpret_cast<const bf16x8*>(a + qd);
        p0 = __builtin_amdgcn_mfma_f32_32x32x16_bf16(b0, qv, p0, 0, 0, 0);
        p1 = __builtin_amdgcn_mfma_f32_32x32x16_bf16(b1, qv, p1, 0, 0, 0); }
}
template <int VB, bool SK>
__device__ __forceinline__ void pv_tile(f32x16* o, int vb0, bf16x8 pa0, bf16x8 pa1, bf16x8 pa2, bf16x8 pa3, bool act) {
    if (SK && !act) return;
#define TRRD(dst, off) asm volatile("ds_read_b64_tr_b16 %0, %1 offset:%2" : "=&v"(dst) : "v"(vb0), "i"(off) : "memory")
#define PV_D0(d0) do { s16x4 l0, l1, l2, l3, h0, h1, h2, h3; constexpr int b_ = VB * SHM_V + v_rd_off(d0, 0, 0);     \
        TRRD(l0, b_); TRRD(h0, b_ + 2048); TRRD(l1, b_ + 4096); TRRD(h1, b_ + 6144); TRRD(l2, b_ + 8192); TRRD(h2, b_ + 10240); TRRD(l3, b_ + 12288); TRRD(h3, b_ + 14336); \
        asm volatile("s_waitcnt lgkmcnt(0)" ::: "memory"); SBAR();                 \
        o[d0] = __builtin_amdgcn_mfma_f32_32x32x16_bf16(pa0, (bf16x8){l0[0], l0[1], l0[2], l0[3], h0[0], h0[1], h0[2], h0[3]}, o[d0], 0, 0, 0);   \
        o[d0] = __builtin_amdgcn_mfma_f32_32x32x16_bf16(pa1, (bf16x8){l1[0], l1[1], l1[2], l1[3], h1[0], h1[1], h1[2], h1[3]}, o[d0], 0, 0, 0);   \
        o[d0] = __builtin_amdgcn_mfma_f32_32x32x16_bf16(pa2, (bf16x8){l2[0], l2[1], l2[2], l2[3], h2[0], h2[1], h2[2], h2[3]}, o[d0], 0, 0, 0);   \
        o[d0] = __builtin_amdgcn_mfma_f32_32x32x16_bf16(pa3, (bf16x8){l3[0], l3[1], l3[2], l3[3], h3[0], h3[1], h3[2], h3[3]}, o[d0], 0, 0, 0); } while (0)
    PV_D0(0); PV_D0(1); PV_D0(2); PV_D0(3);
#undef PV_D0
#undef TRRD
}
template <class TIn, class TOut> struct BlockRef { const TIn* Q; const TIn* K; const TIn* V; TOut* O; int P0; };
template <class TIn> struct Seam {
    bf16x8 qr[8];
    bf16x8 st_v0, st_v1, st_k0, st_k1; f32x4 sf0, sf1, sf2, sf3;
    f32x4 tq[16];
};
__device__ __forceinline__ int swa_jlo(int P0, int W) { const int lowk = P0 - W + 1; return lowk > 0 ? lowk / KVBLK : 0; }
template <int PHS, bool REV> __device__ __forceinline__ int first_tile(int P0, int W, int skv) {
    if (!REV) return swa_jlo(P0, W);
    int jh = (P0 + (PHS ? 2 * QBLK : QB) - 1) / KVBLK + 1; if (jh > skv / KVBLK) jh = skv / KVBLK; return jh - 1; }
#define ROW(p, k0, rr) ((p) + (size_t)((k0) + (rr)) * D + sc)
#define ROWU(p, k0, c32) ((p) + ((size_t)(k0) + (c32)) * D)
#define VMW() asm volatile("s_waitcnt vmcnt(0)" ::: "memory")
#define VMWN(n) asm volatile("s_waitcnt vmcnt(%0)" :: "i"(n) : "memory")
#define SLOAD_H(Kp, Vp, k0) do { S.st_v0 = load8<TIn>(ROWU(Vp, k0, 0) + voff); S.st_v1 = load8<TIn>(ROWU(Vp, k0, 32) + voff);              \
                         S.st_k0 = load8<TIn>(ROWU(Kp, k0, 0) + voff); S.st_k1 = load8<TIn>(ROWU(Kp, k0, 32) + voff); } while (0)
#define SWRITE_HK(bf) do { *(bf16x8*)(K_lds + (bf) * SHM_K + kws) = S.st_k0; *(bf16x8*)(K_lds + (bf) * SHM_K + kws + 32 * 256) = S.st_k1; } while (0)
#define SWRITE_HV(bf) do { *(bf16x8*)(V_lds + (bf) * SHM_V + vst0) = S.st_v0; *(bf16x8*)(V_lds + (bf) * SHM_V + vst1) = S.st_v1; } while (0)
#define SWRITE_H(bf) do { SWRITE_HV(bf); SWRITE_HK(bf); } while (0)
#define SLOAD_F(p, k0) do { S.sf0 = *(const f32x4*)ROW(p, k0, sr); S.sf1 = *(const f32x4*)(ROW(p, k0, sr) + 4);                \
                            S.sf2 = *(const f32x4*)ROW(p, k0, 32 + sr); S.sf3 = *(const f32x4*)(ROW(p, k0, 32 + sr) + 4); } while (0)
#define SWRITE_KF(bf) do { *(bf16x8*)(K_lds + (bf) * SHM_K + kws) = pack8(S.sf0, S.sf1); *(bf16x8*)(K_lds + (bf) * SHM_K + kws + 32 * 256) = pack8(S.sf2, S.sf3); } while (0)
#define SWRITE_VF(bf) do { *(bf16x8*)(V_lds + (bf) * SHM_V + vst0) = pack8(S.sf0, S.sf1); *(bf16x8*)(V_lds + (bf) * SHM_V + vst1) = pack8(S.sf2, S.sf3); } while (0)
template <class TIn, class TOut, int PHS = 0, bool REV = false>
__device__ __forceinline__ void causal_swa_prime(const BlockRef<TIn, TOut>& cur, int skv, int W, char* lds, Seam<TIn>& S) {
    constexpr bool F32 = same_t<TIn, float>::v;
    const int tid = threadIdx.x, wid = __builtin_amdgcn_readfirstlane(tid >> 6), lane = tid & 63, r32 = lane & 31, hi = lane >> 5;
    const int sr = tid >> 4, sc = (tid & 15) * 8, kws = KSWZ(sr, sc * 2); char* K_lds = lds + 2 * SHM_V; const unsigned voff = (unsigned)(sr * D + sc);
    const int kb0 = first_tile<PHS, REV>(cur.P0, W, skv) * KVBLK;
    const int wrow = PHS ? (wid >> 1) * PHS + (wid & 1) * QBLK : wid * QBLK;
    for (int d0 = 0; d0 < 8; ++d0) S.qr[d0] = load8<TIn>(cur.Q + (size_t)(wrow + r32) * D + d0 * 16 + hi * 8);
    if constexpr (F32) { SLOAD_F((const float*)cur.K, kb0); VMW(); SWRITE_KF(0); SBAR(); SLOAD_F((const float*)cur.V, kb0); }
    else { SLOAD_H(cur.K, cur.V, kb0); VMW(); SWRITE_HK(0); }
    __syncthreads();
}
template <class TIn, class TOut, bool SK_, bool BIAS, bool SINK, int PHS = 0, bool REV = false>
__device__ __forceinline__ void causal_swa_block(const BlockRef<TIn, TOut>& cur, const BlockRef<TIn, TOut>& nxt, int skv, int W, char* lds, Seam<TIn>& S, const float* sinkp) {
    constexpr bool F32 = same_t<TIn, float>::v;
    const int tid = threadIdx.x, wid = __builtin_amdgcn_readfirstlane(tid >> 6), lane = tid & 63, r32 = lane & 31, hi = lane >> 5;
    const int j_lo = swa_jlo(cur.P0, W);
    constexpr int QSPAN = PHS ? 2 * QBLK : QB;
    int j_hi = (cur.P0 + QSPAN - 1) / KVBLK + 1; if (j_hi > skv / KVBLK) j_hi = skv / KVBLK;
    const int NT = j_hi - j_lo;
    const int kbn = first_tile<PHS, REV>(nxt.P0, W, skv) * KVBLK;
    const int wrow = PHS ? (wid >> 1) * PHS + (wid & 1) * QBLK : wid * QBLK, wpos = PHS ? (wid & 1) * QBLK : wid * QBLK;
    const float sink_raw = SINK ? sinkp[PHS ? (wid >> 1) : 0] * (1.f / SCALE) : 0.f;
    const int qlo = cur.P0 + wpos, qm = qlo + r32 - 4 * hi;
    char* V_lds = lds; char* K_lds = lds + 2 * SHM_V;
    const int qd0 = ATT_Q_OFF + wid * 8192 - 2 * SHM_V;
    { char* Qw = lds + ATT_Q_OFF + wid * 8192;
#pragma unroll
      for (int d0 = 0; d0 < 8; ++d0) *reinterpret_cast<bf16x8*>(Qw + KSWZ(r32, (d0 * 16 + hi * 8) * 2)) = S.qr[d0]; }
    float* ws = (float*)(lds + 2 * SHM_V + 2 * SHM_K) + wid * 64; float* li_l = ws, * al_l = ws + 32;
    float m_reg = SINK ? sink_raw : -1e30f, l_reg = SINK ? 1.f : 0.f; f32x16 o[4] = {};
    const float* bias_l = (const float*)(lds + ATT_BIAS_OFF) + 4 * hi;
#define BIASP(t) (bias_l + KBASE(t))
    const unsigned voff = (unsigned)((tid >> 4) * D + (tid & 15) * 8);
    const int sr = tid >> 4, sc = (tid & 15) * 8, vst0 = v_st(sr, sc), vst1 = vst0 + 8192, kws = KSWZ(sr, sc * 2);
    const int vb0 = (int)(uintptr_t)V_lds + v_rd_base(lane);
    const TIn* Kh = cur.K; const TIn* Vh = cur.V;
#define RESC(a) do { if (__any((a) < 1.f)) { if (hi == 0) al_l[r32] = (a); asm volatile("s_waitcnt lgkmcnt(0)" ::: "memory");              \
                     for (int d_ = 0; d_ < 4; ++d_) for (int r = 0; r < 16; ++r) o[d_][r] *= al_l[crow(r, hi)]; } } while (0)
#define KBASE(t) ((REV ? j_hi - 1 - (t) : j_lo + (t)) * KVBLK)
#define ACT(t) (KBASE(t) <= qlo + QBLK - 1 && KBASE(t) + KVBLK - 1 >= qlo - W + 1)
#define MASKT(P0_, P1_, t) do { const int kb_ = KBASE(t); if ((!SK || ACT(t)) && (kb_ + KVBLK - 1 > qlo || kb_ <= qlo + QBLK - 1 - W)) mask_tile(P0_, P1_, qm - kb_, (unsigned)W); } while (0)
    constexpr int NQL = F32 ? 16 : 8;
    constexpr bool SK = SK_;
#define SEAM_K0() do { VMWN(NQL); if constexpr (F32) { SWRITE_KF(0); SBAR(); SLOAD_F((const float*)nxt.V, kbn); } else { SWRITE_HK(0); } SBAR(); } while (0)
    f32x16 pA0, pA1, pB0, pB1; float mnA, mnB, alA, alB; bf16x8 pa0, pa1, pa2, pa3;
    if constexpr (F32) { VMW(); SWRITE_VF(0); SBAR(); } else { SWRITE_HV(0); SBAR(); }
    if (NT > 1) { if constexpr (F32) SLOAD_F((const float*)Kh, KBASE(1)); else SLOAD_H(Kh, Vh, KBASE(1)); }
    SBAR(); qkt<0, SK, BIAS>(pA0, pA1, K_lds, r32, hi, qd0, ACT(0), BIASP(0));
    if constexpr (F32) { if (NT > 1) { VMW(); SWRITE_KF(1); SBAR(); SLOAD_F((const float*)Vh, KBASE(1)); } }
    MASKT(pA0, pA1, 0); partialSM(pA0, pA1, m_reg, mnA, alA);
    if (NT > 1) { VMW(); if constexpr (F32) { SWRITE_VF(1); SBAR(); if (NT > 2) SLOAD_F((const float*)Kh, KBASE(2)); } else SWRITE_H(1); }
    __syncthreads();
#define HALF_STEP(PX0, PX1, mnX, alX, PY0, PY1, alY, t, KB, VB, SB) do {                                                      \
        SBAR(); qkt<KB, SK, BIAS>(PX0, PX1, K_lds, r32, hi, (KB ? qd0 - SHM_K : qd0), ACT(t), BIASP(t));                                             \
        finishSM(PY0, PY1, alY, l_reg, pa0, pa1, pa2, pa3); SBAR();                                                           \
        if ((t) + 1 < NT) { if constexpr (F32) { VMW(); SWRITE_KF(SB); SBAR(); SLOAD_F((const float*)Vh, KBASE((t) + 1)); }  \
                            else { SLOAD_H(Kh, Vh, KBASE((t) + 1)); } SBAR(); }                                               \
        pv_tile<VB, SK>(o, vb0, pa0, pa1, pa2, pa3, ACT((t) - 1)); MASKT(PX0, PX1, (t)); partialSM(PX0, PX1, m_reg, mnX, alX);                                        \
        __syncthreads();                                                                                                      \
        if ((t) + 1 < NT) { VMW(); if constexpr (F32) { SWRITE_VF(SB); SBAR(); if ((t) + 2 < NT) SLOAD_F((const float*)Kh, KBASE((t) + 2)); } \
                            else { SWRITE_H(SB); } }                                                                          \
        RESC(alX); __syncthreads(); } while (0)
    for (int t = 1; t + 1 < NT; t += 2) {
        HALF_STEP(pB0, pB1, mnB, alB, pA0, pA1, alA, t, 1, 0, 0);
        HALF_STEP(pA0, pA1, mnA, alA, pB0, pB1, alB, t + 1, 0, 1, 1);
    }
    const bool even = (NT & 1) == 0;
    if (even) { SBAR(); qkt<1, SK, BIAS>(pB0, pB1, K_lds, r32, hi, qd0 - SHM_K, ACT(NT - 1), BIASP(NT - 1)); SBAR(); }
#define QROW(e) (nxt.Q + (size_t)(wid * QBLK + r32) * D + ((e) >> 1) * 16 + hi * 8 + ((e) & 1) * 4)
    if constexpr (F32) { SLOAD_F((const float*)nxt.K, kbn); SBAR();
#pragma unroll
        for (int e = 0; e < 8; ++e) S.tq[e] = *(const f32x4*)QROW(e); }
    else { SLOAD_H(nxt.K, nxt.V, kbn); SBAR();
#pragma unroll
        for (int d0 = 0; d0 < 8; ++d0) S.qr[d0] = load8<TIn>(nxt.Q + (size_t)(wrow + r32) * D + d0 * 16 + hi * 8); }
    SBAR();
    finishSM(pA0, pA1, alA, l_reg, pa0, pa1, pa2, pa3); SBAR();
    if constexpr (F32) {
#pragma unroll
        for (int e = 8; e < 16; ++e) S.tq[e] = *(const f32x4*)QROW(e); SBAR(); }
#undef QROW
    pv_tile<0, SK>(o, vb0, pa0, pa1, pa2, pa3, ACT(even ? NT - 2 : NT - 1));
    if (even) { MASKT(pB0, pB1, NT - 1); partialSM(pB0, pB1, m_reg, mnB, alB); __syncthreads(); RESC(alB);
        finishSM(pB0, pB1, alB, l_reg, pa0, pa1, pa2, pa3); SBAR(); pv_tile<1, SK>(o, vb0, pa0, pa1, pa2, pa3, ACT(NT - 1)); }
    SBAR(); SEAM_K0();
    if (hi == 0) li_l[r32] = l_reg; asm volatile("s_waitcnt lgkmcnt(0)" ::: "memory");
    float rli[16];
#pragma unroll
    for (int r = 0; r < 16; ++r) rli[r] = __builtin_amdgcn_rcpf(li_l[crow(r, hi)]);
    TOut* Ow = cur.O + (size_t)wpos * OSTR + (PHS ? (wid >> 1) * D : 0);
#pragma unroll
    for (int r = 0; r < 16; ++r) { const int orow = crow(r, hi);
#pragma unroll
        for (int d0 = 0; d0 < 4; ++d0) { const float v = o[d0][r] * rli[r];
            if constexpr (same_t<TOut, float>::v) { Ow[(size_t)orow * OSTR + d0 * 32 + r32] = v; }
            else { const float vn = __shfl_xor(v, 1);
                   if ((r32 & 1) == 0) *(unsigned*)(Ow + (size_t)orow * OSTR + d0 * 32 + r32) = cvtpk(v, vn); } } }
    if constexpr (F32) {
#pragma unroll
        for (int d0 = 0; d0 < 8; ++d0) S.qr[d0] = pack8(S.tq[2 * d0], S.tq[2 * d0 + 1]); }
    __syncthreads();
#undef RESC
#undef KBASE
#undef BIASP
#undef ACT
#undef MASKT
#undef SEAM_K0
#undef HALF_STEP
}
#undef ROW
#undef VMW
#undef VMWN
#undef SLOAD_H
#undef SWRITE_HK
#undef SWRITE_HV
#undef SWRITE_H
#undef SLOAD_F
#undef SWRITE_KF
#undef SWRITE_VF
#undef KSWZ
#undef SBAR
}
#define LAS __attribute__((address_space(3)))
typedef unsigned short bf16r;
typedef float f32x4 __attribute__((ext_vector_type(4)));
typedef unsigned v4u __attribute__((ext_vector_type(4)));
typedef unsigned v2u __attribute__((ext_vector_type(2)));
constexpr int NWAVES = 8, NTHR = 512;
constexpr int BATCH = 8, SEQ = 2048, DM = 2048, M = BATCH * SEQ, DFF = 8192, NIN = 4616, NINP = 4864, NMOD = 6 * DM;
constexpr float EPS = 1e-6f;
constexpr int KS = 16;
#ifndef MK_N_LAUNCHES
#define MK_N_LAUNCHES 1
#endif
constexpr int N_PHASES = 9;
constexpr size_t MiB = 1u << 20;
constexpr size_t WS_WIN = 1 * MiB, WS_WOUT = 20 * MiB, WS_WUP = 28 * MiB, WS_WDN = 60 * MiB;
constexpr size_t WS_MODP = 92 * MiB, WS_MODF = 98 * MiB, WS_COS = 99 * MiB, WS_SIN = 99 * MiB + 512 * 1024, WS_LOGF = 100 * MiB, WS_SS1 = 101 * MiB, WS_SS2 = 103 * MiB;
constexpr size_t WS_QF = 128 * MiB, WS_KF = 160 * MiB, WS_VF = 192 * MiB, WS_SQ = 224 * MiB, WS_SK = 256 * MiB, WS_SV = 264 * MiB, WS_ATT = 272 * MiB;
constexpr size_t WS_MIX = 128 * MiB;
constexpr size_t WS_U = 128 * MiB;
constexpr size_t WS_XN = 384 * MiB, WS_Y = 384 * MiB;
constexpr size_t WS_X1B = 448 * MiB;
constexpr size_t WS_END = 512 * MiB;
constexpr int LDS_BYTES = 147456;

__device__ __forceinline__ float wave_sum(float v) {
#pragma unroll
    for (int o = 1; o < 64; o <<= 1) v += __shfl_xor(v, o);
    return v;
}
__device__ __forceinline__ unsigned pk2(float lo, float hi) { return pg8::cvt_pk_bf16(lo, hi); }
__device__ __forceinline__ float bflo(unsigned u) { return __uint_as_float(u << 16); }
__device__ __forceinline__ float bfhi(unsigned u) { return __uint_as_float(u & 0xffff0000u); }

__device__ __forceinline__ int rope_dim(int p) { return 4 * (p >> 3) + (p & 3) + 64 * ((p >> 2) & 1); }
template <int MAP> __device__ __forceinline__ int srccol(int n) {
    if (MAP == 0) return n;
    if (n < 3072) return n;
    if (n < 4096) { const int r = n - 3072; return 3080 + (r & ~127) + rope_dim(r & 127); }
    if (n < 4352) { const int r = n - 4096; return 4104 + (r & ~127) + rope_dim(r & 127); }
    if (n < 4608) return 4360 + (n - 4352);
    if (n < 4616) return 3072 + (n - 4608);
    return -1;
}
template <int MAP, bool NTS = false> __device__ __forceinline__ void transpose_item(const float* W, int K, int Nsrc, int nblk, bf16r* WT, LAS float* scr, int item, int lane) {
    const int kb = item / nblk, nb = item % nblk, k0 = 64 * kb, n0 = 32 * nb;
    const int sc = srccol<MAP>(n0 + (lane & 31));
    float tv[32];
#pragma unroll
    for (int i = 0; i < 32; ++i) { const int kk = 2 * i + (lane >> 5); tv[i] = sc >= 0 ? __builtin_nontemporal_load(&W[(size_t)(k0 + kk) * Nsrc + sc]) : 0.f; }
#pragma unroll
    for (int i = 0; i < 32; ++i) { const int kk = 2 * i + (lane >> 5); scr[kk * 33 + (lane & 31)] = tv[i]; }
    asm volatile("s_waitcnt lgkmcnt(0)" ::: "memory");
    const int c = lane & 7;
#pragma unroll
    for (int j = 0; j < 4; ++j) { const int n = (lane >> 3) + 8 * j; const LAS float* s = scr + (8 * c) * 33 + n;
        v4u o; o.x = pk2(s[0 * 33], s[1 * 33]); o.y = pk2(s[2 * 33], s[3 * 33]); o.z = pk2(s[4 * 33], s[5 * 33]); o.w = pk2(s[6 * 33], s[7 * 33]);
        if (NTS) __builtin_nontemporal_store(o, (v4u*)(WT + (size_t)(n0 + n) * K + k0 + 8 * c)); else *(v4u*)(WT + (size_t)(n0 + n) * K + k0 + 8 * c) = o; }
    asm volatile("s_waitcnt lgkmcnt(0)" ::: "memory");
}

#define XB_TMO      128
#define XB_XCNT(j)  (256  + 64 * (j))
#define XB_XSUB(j)  (1280 + 64 * (j))
#define XB_XGEN(j)  (2304 + 64 * (j))
#define XB_TOP      3328
#define XB_TOPGEN   3392
#define XCD_BAR_WORDS 3456
#define XB_SPIN_CAP (1u << 18)

__device__ __forceinline__ unsigned xb_ld(unsigned* p)              { return __hip_atomic_load(p, __ATOMIC_RELAXED, __HIP_MEMORY_SCOPE_AGENT); }
__device__ __forceinline__ unsigned xb_add(unsigned* p, unsigned v) { return __hip_atomic_fetch_add(p, v, __ATOMIC_RELAXED, __HIP_MEMORY_SCOPE_AGENT); }
__device__ __forceinline__ unsigned xb_xcc_id() { return (unsigned)__builtin_amdgcn_s_getreg((3 << 11) | 20) & 0xFu; }
#define XB_SPIN(cond, bar) do { unsigned _sp = 0; while (cond) { __builtin_amdgcn_s_sleep(1); \
    if ((++_sp & 255u) == 0u) { if (xb_ld(&(bar)[XB_TMO])) break; if (_sp > XB_SPIN_CAP) { atomicAdd(&(bar)[XB_TMO], 1u); break; } } } } while (0)

struct XcdBarrier {
    unsigned* bar; unsigned x;
    volatile LAS unsigned* st;
};

__device__ __forceinline__ XcdBarrier xcd_barrier_post(unsigned* bar, volatile LAS unsigned* st) {
    XcdBarrier b; b.bar = bar; b.x = xb_xcc_id(); b.st = st;
    if (threadIdx.x == 0) (void)xb_add(&bar[XB_XCNT(b.x)], 1u);
    return b;
}
__device__ __forceinline__ void xcd_barrier_complete(unsigned* bar, unsigned x, unsigned& nloc, unsigned& nx) {
    const unsigned G = gridDim.x * gridDim.y * gridDim.z;
    unsigned sum, cnt, mine, sp = 0u;
    for (;;) {
        sum = 0u; cnt = 0u; mine = 0u;
#pragma unroll
        for (unsigned j = 0; j < 16; ++j) { const unsigned c = xb_ld(&bar[XB_XCNT(j)]); sum += c; cnt += (c > 0u) ? 1u : 0u; mine = (j == x) ? c : mine; }
        if (sum == G) break;
        __builtin_amdgcn_s_sleep(1);
        if ((++sp & 255u) == 0u) { if (xb_ld(&bar[XB_TMO])) break; if (sp > XB_SPIN_CAP) { atomicAdd(&bar[XB_TMO], 1u); break; } }
    }
    nloc = mine > 0u ? mine : 1u; nx = cnt > 0u ? cnt : 1u;
}

__device__ __forceinline__ void xcd_barrier(const XcdBarrier& b) {
    asm volatile("s_waitcnt vmcnt(0)" ::: "memory");
    __syncthreads();
    if (threadIdx.x == 0) {
        unsigned* bar = b.bar;
        __builtin_amdgcn_s_waitcnt(0);
        unsigned nloc = b.st[0], nx = b.st[1];
        if (nloc == 0u) { xcd_barrier_complete(bar, b.x, nloc, nx); b.st[0] = nloc; b.st[1] = nx; }
        const unsigned old = xb_add(&bar[XB_XSUB(b.x)], 1u);
        const unsigned gen = old / nloc;
        if (old + 1u == (gen + 1u) * nloc) {
            __builtin_amdgcn_fence(__ATOMIC_RELEASE, "agent");
            asm volatile("s_waitcnt vmcnt(0)" ::: "memory");
            const unsigned og = xb_add(&bar[XB_TOP], 1u);
            const unsigned tg = og / nx;
            if (og + 1u == (tg + 1u) * nx) xb_add(&bar[XB_TOPGEN], 1u);
            else XB_SPIN(xb_ld(&bar[XB_TOPGEN]) == tg, bar);
            __builtin_amdgcn_fence(__ATOMIC_ACQUIRE, "agent");
            xb_add(&bar[XB_XGEN(b.x)], 1u);
            asm volatile("s_waitcnt vmcnt(0)" ::: "memory");
        } else {
            XB_SPIN(xb_ld(&bar[XB_XGEN(b.x)]) == gen, bar);
            __builtin_amdgcn_fence(__ATOMIC_ACQUIRE, "agent");
            asm volatile("s_waitcnt vmcnt(0)" ::: "memory");
        }
    }
    __syncthreads();
}

constexpr int LDS_MISC_OFF = 147456 - 128;
struct Args { const float* in[14]; float* out; unsigned char* ws; int ph_lo, ph_hi; };

__global__ void __launch_bounds__(NTHR, 2) fwd_mega(Args a) {
    extern __shared__ __attribute__((aligned(16))) unsigned char lds[];
    LAS unsigned char* lds3 = (LAS unsigned char*)lds;
    const int tid = threadIdx.x, lane = tid & 63, wid = __builtin_amdgcn_readfirstlane(tid >> 6);
    const int G = gridDim.x, bx = blockIdx.x, vcu = (G % 8 == 0) ? (bx % 8) * (G / 8) + bx / 8 : bx;
    const float *x = a.in[0], *cin = a.in[1], *w_mod = a.in[2], *b_mod = a.in[3], *g_pre_mix = a.in[4], *g_post_mix = a.in[5], *w_in = a.in[6], *b_forget = a.in[7],
                *swa_sinks = a.in[8], *w_out = a.in[9], *g_pre_mlp = a.in[10], *g_post_mlp = a.in[11], *w_up = a.in[12], *w_down = a.in[13];
    float* out = a.out; unsigned char* ws = a.ws;
    bf16r *WIN_T = (bf16r*)(ws + WS_WIN), *WOUT_T = (bf16r*)(ws + WS_WOUT), *WUP_T = (bf16r*)(ws + WS_WUP), *WDN_T = (bf16r*)(ws + WS_WDN);
    float *MODP = (float*)(ws + WS_MODP), *MODF = (float*)(ws + WS_MODF), *COS = (float*)(ws + WS_COS), *SIN = (float*)(ws + WS_SIN), *LOGF = (float*)(ws + WS_LOGF),
          *SS1 = (float*)(ws + WS_SS1), *SS2 = (float*)(ws + WS_SS2);
    bf16r *QF = (bf16r*)(ws + WS_QF), *KF = (bf16r*)(ws + WS_KF), *VF = (bf16r*)(ws + WS_VF), *SQ = (bf16r*)(ws + WS_SQ), *SKb = (bf16r*)(ws + WS_SK), *SVb = (bf16r*)(ws + WS_SV),
          *ATT = (bf16r*)(ws + WS_ATT), *MIX = (bf16r*)(ws + WS_MIX), *U = (bf16r*)(ws + WS_U), *XN = (bf16r*)(ws + WS_XN), *Y = (bf16r*)(ws + WS_Y), *X1B = (bf16r*)(ws + WS_X1B);
    const int lo = a.ph_lo, hi = a.ph_hi;
#ifndef PH_MASK
#define PH_MASK 0x1ff
#endif
#define IN(k) (((PH_MASK >> (k)) & 1) && lo <= (k) && (k) < hi)
#define SEAM(k) do { if (IN(k) && IN((k) + 1)) xcd_barrier(bar); } while (0)
    if (lo < 0) cg::this_grid().sync();
    volatile LAS unsigned* MISC = (volatile LAS unsigned*)(lds3 + LDS_MISC_OFF);
    if (tid < 32) MISC[tid] = 0u;
    __syncthreads();
    XcdBarrier bar = xcd_barrier_post((unsigned*)ws + 1024, MISC + 8);

    if (IN(0)) {
        for (int e = bx * NTHR + tid; e < SEQ * 64; e += G * NTHR) { const int pos = e >> 6, i = e & 63;
            const float inv = exp2f(-(float)i * (13.287712379549449f / 64.f)), ang = (float)pos * inv;
            const double rev = (double)ang * 0.15915494309189535; const float fr = (float)(rev - rint(rev));
            COS[e] = __builtin_amdgcn_cosf(fr); SIN[e] = __builtin_amdgcn_sinf(fr); }
        LAS float* condL = (LAS float*)lds3; LAS float* red = (LAS float*)(lds3 + 65536);
        { float cvv[32];
#pragma unroll
          for (int q = 0; q < 32; ++q) cvv[q] = cin[tid + q * NTHR];
#pragma unroll
          for (int q = 0; q < 32; ++q) { const int i = tid + q * NTHR, b = i >> 11, k = i & 2047; const float cv = cvv[q]; condL[k * 8 + b] = cv / (1.f + __expf(-cv)); } }
        __syncthreads();
        for (int item = bx; item < 48 * KS; item += G) { const int cgp = item % 48, kc = item / 48, col = cgp * 256 + lane * 4, k0 = kc * 128 + wid * 16;
            f32x4 ac[8];
#pragma unroll
            for (int b = 0; b < 8; ++b) ac[b] = (f32x4){0.f, 0.f, 0.f, 0.f};
            f32x4 wv[16];
#pragma unroll
            for (int kk = 0; kk < 16; ++kk) wv[kk] = __builtin_nontemporal_load((const f32x4*)(w_mod + (size_t)(k0 + kk) * NMOD + col));
#pragma unroll
            for (int kk = 0; kk < 16; ++kk) { const f32x4 w = wv[kk];
                const f32x4 c0 = *(const LAS f32x4*)(condL + (k0 + kk) * 8), c1 = *(const LAS f32x4*)(condL + (k0 + kk) * 8 + 4);
                ac[0] += w * c0[0]; ac[1] += w * c0[1]; ac[2] += w * c0[2]; ac[3] += w * c0[3]; ac[4] += w * c1[0]; ac[5] += w * c1[1]; ac[6] += w * c1[2]; ac[7] += w * c1[3]; }
#pragma unroll
            for (int b = 0; b < 8; ++b) *(LAS f32x4*)(red + (wid * 8 + b) * 256 + lane * 4) = ac[b];
            __syncthreads();
            { const int b = tid >> 6, c4 = (tid & 63) * 4; f32x4 s = (f32x4){0.f, 0.f, 0.f, 0.f};
#pragma unroll
              for (int w = 0; w < 8; ++w) s += *(const LAS f32x4*)(red + (w * 8 + b) * 256 + c4);
              *(f32x4*)(MODP + (size_t)(kc * 8 + b) * NMOD + cgp * 256 + c4) = s; }
            __syncthreads();
        }
        LAS float* scr = (LAS float*)(lds3 + 63488 + wid * 8448);
        const int gw = vcu * NWAVES + wid, NGW = G * NWAVES;
        constexpr int I_IN = (DM / 64) * (NINP / 32), I_OUT = (DM / 64) * (DM / 32);
        for (int it = gw; it < I_IN + I_OUT; it += NGW) { int r = it;
            if (r < I_IN) { transpose_item<1>(w_in, DM, NIN, NINP / 32, WIN_T, scr, r, lane); continue; } r -= I_IN;
            transpose_item<0>(w_out, DM, DM, DM / 32, WOUT_T, scr, r, lane); }
        __syncthreads();
    }
    SEAM(0);

    if (IN(1)) {
        for (int i = bx * NTHR + tid; i < BATCH * NMOD; i += G * NTHR) { const int b = i / NMOD, n = i - b * NMOD; float s = b_mod[n];
#pragma unroll
            for (int p = 0; p < KS; ++p) s += MODP[(size_t)(p * 8 + b) * NMOD + n];
            MODF[i] = s; }
        LAS float* gsL = (LAS float*)lds3; LAS float* shL = gsL + DM;
        for (int unit = vcu; unit < M / 64; unit += G) { const int b = unit >> 5;
#pragma unroll
            for (int c = tid; c < DM; c += NTHR) { float sh = b_mod[c], sc = b_mod[DM + c];
#pragma unroll
                for (int p = 0; p < KS; ++p) { sh += MODP[(size_t)(p * 8 + b) * NMOD + c]; sc += MODP[(size_t)(p * 8 + b) * NMOD + DM + c]; }
                gsL[c] = g_pre_mix[c] * (1.f + sc); shL[c] = sh; }
            __syncthreads();
            const size_t row0 = (size_t)unit * 64 + wid * 8;
#define P1_LOAD(v, row) do { const f32x4* xr_ = (const f32x4*)(x + (row) * DM) + lane; _Pragma("unroll") for (int j = 0; j < 8; ++j) v[j] = __builtin_nontemporal_load(&xr_[64 * j]); } while (0)
#define P1_PROC(v, row) do { float ss = 0.f; _Pragma("unroll") for (int j = 0; j < 8; ++j) ss += (v[j][0] * v[j][0] + v[j][1] * v[j][1]) + (v[j][2] * v[j][2] + v[j][3] * v[j][3]); \
                const float rstd = rsqrtf(wave_sum(ss) * (1.f / DM) + EPS); v2u* o8 = (v2u*)(XN + (row) * DM) + lane; \
                _Pragma("unroll") for (int j = 0; j < 8; ++j) { const f32x4 g4 = *(const LAS f32x4*)(gsL + 4 * (64 * j + lane)), s4 = *(const LAS f32x4*)(shL + 4 * (64 * j + lane)); \
                    const f32x4 h = v[j] * rstd * g4 + s4; v2u w; w.x = pk2(h[0], h[1]); w.y = pk2(h[2], h[3]); o8[64 * j] = w; } } while (0)
            { f32x4 va[8], vb[8]; P1_LOAD(va, row0);
#pragma unroll
              for (int i = 0; i < 8; i += 2) { P1_LOAD(vb, row0 + i + 1); P1_PROC(va, row0 + i); if (i + 2 < 8) P1_LOAD(va, row0 + i + 2); P1_PROC(vb, row0 + i + 1); } }
#undef P1_LOAD
#undef P1_PROC
            __syncthreads();
        }
    }
    SEAM(1);

    if (IN(2)) {
        pg8::Gemm g{XN, WIN_T, M, NINP, DM}; pg8::StaticOrder S; S.init(M, NINP, G, bx, 4, 2);
        pg8::EpiInProj E{QF, KF, VF, SQ, SKb, SVb, LOGF, COS, SIN, b_forget};
        pg8::gemm_phase<pg8::EpiInProj, pg8::StaticOrder, true, true>(lds3, g, S, E);
        { constexpr int I_UP = (DM / 64) * (DFF / 32), I_DN = (DFF / 64) * (DM / 32);
          constexpr unsigned PER = (unsigned)(I_UP + I_DN) / 8u; const unsigned grp = (unsigned)bx & 7u;
          unsigned* ctr = (unsigned*)ws + 8192 + 64 * grp; LAS float* scr = (LAS float*)(lds3 + wid * 8448);
          for (;;) { unsigned it0 = 0u; if (lane == 0) it0 = __hip_atomic_fetch_add(ctr, 2u, __ATOMIC_RELAXED, __HIP_MEMORY_SCOPE_AGENT);
              it0 = (unsigned)__builtin_amdgcn_readfirstlane((int)it0); if (it0 >= PER) break;
              for (unsigned q = 0; q < 2u; ++q) { const unsigned it = grp * PER + it0 + q;
                  if (it < (unsigned)I_UP) transpose_item<0, true>(w_up, DM, DFF, DFF / 32, WUP_T, scr, (int)it, lane); else transpose_item<0, true>(w_down, DFF, DM, DM / 32, WDN_T, scr, (int)it - I_UP, lane); } } }
    }
    SEAM(2);

    if (IN(3)) {
        typedef att::BlockRef<att::bf16, att::bf16> BR;
        char* ldsg = (char*)lds;
        { const int it = vcu & 255; const int b = it >> 5, j = it & 31, h = j >> 2, y = j & 3;
            { float* biasL = (float*)(ldsg + att::ATT_BIAS_OFF); float* scanL = (float*)(ldsg + att::ATT_SCAN_OFF);
              const float* lf = LOGF + ((size_t)b * SEQ + 4 * tid) * 8 + h;
              const float v0 = lf[0], v1 = lf[8], v2 = lf[16], v3 = lf[24]; const float c0 = v0, c1 = c0 + v1, c2 = c1 + v2, c3 = c2 + v3;
              float T = c3;
#pragma unroll
              for (int o = 1; o < 64; o <<= 1) { const float n = __shfl_up(T, o); if (lane >= o) T += n; }
              if (lane == 63) scanL[wid] = T;
              __syncthreads();
              float woff = 0.f;
              for (int w = 0; w < wid; ++w) woff += scanL[w];
              const float base = woff + (T - c3), k = -1.f / att::SCALE;
              *(f32x4*)(biasL + 4 * tid) = (f32x4){(base + c0) * k, (base + c1) * k, (base + c2) * k, (base + c3) * k};
              __syncthreads(); }
            att::Seam<att::bf16> S;
#ifndef NO_FOX
            { BR r0, r1; const size_t hb = (size_t)(b * 8 + h) * SEQ * 128;
              r0.K = r1.K = (const att::bf16*)KF + hb; r0.V = r1.V = (const att::bf16*)VF + hb;
              r0.Q = (const att::bf16*)QF + hb + (size_t)(y * 256) * 128; r1.Q = (const att::bf16*)QF + hb + (size_t)((7 - y) * 256) * 128;
              r0.O = (att::bf16*)ATT + ((size_t)b * SEQ + y * 256) * DM + h * 128; r1.O = (att::bf16*)ATT + ((size_t)b * SEQ + (7 - y) * 256) * DM + h * 128;
              r0.P0 = y * 256; r1.P0 = (7 - y) * 256;
              att::causal_swa_prime<att::bf16, att::bf16, 0, true>(r0, SEQ, 0x40000000, ldsg, S);
              for (int p = 0; p < 2; ++p) att::causal_swa_block<att::bf16, att::bf16, false, true, false, 0, true>(p ? r1 : r0, r1, SEQ, 0x40000000, ldsg, S, nullptr); }
#endif
#ifndef NO_SWA
            { BR r0, r1; const int kvh = j >> 4, c0 = 2 * (j & 15);
              const size_t hq = (size_t)(b * 8 + 4 * kvh) * SEQ * 128, hk = (size_t)(b * 2 + kvh) * SEQ * 128;
              r0.K = r1.K = (const att::bf16*)SKb + hk; r0.V = r1.V = (const att::bf16*)SVb + hk;
              r0.Q = (const att::bf16*)SQ + hq + (size_t)(c0 * 64) * 128; r1.Q = (const att::bf16*)SQ + hq + (size_t)((c0 + 1) * 64) * 128;
              r0.O = (att::bf16*)ATT + ((size_t)b * SEQ + c0 * 64) * DM + 1024 + 4 * kvh * 128; r1.O = (att::bf16*)ATT + ((size_t)b * SEQ + (c0 + 1) * 64) * DM + 1024 + 4 * kvh * 128;
              r0.P0 = c0 * 64; r1.P0 = (c0 + 1) * 64;
              const float* sinkp = swa_sinks + 4 * kvh;
              att::causal_swa_prime<att::bf16, att::bf16, SEQ>(r0, SEQ, 128, ldsg, S);
              BR cur = r0; for (int p = 0; p < 2; ++p) { att::causal_swa_block<att::bf16, att::bf16, true, false, true, SEQ>(cur, r1, SEQ, 128, ldsg, S, sinkp); cur = r1; } }
#endif
        }
    }
    SEAM(3);

    if (IN(4)) {
        pg8::Gemm g{ATT, WOUT_T, M, DM, DM, (bx & 7) * 4}; pg8::StaticOrder S; S.init(M, DM, G, bx, 4);
        pg8::EpiBf16SS E{MIX, DM, SS1};
        pg8::gemm_phase<pg8::EpiBf16SS, pg8::StaticOrder, true, true>(lds3, g, S, E);
    }
    SEAM(4);

    if (IN(5)) {
        LAS float* AL = (LAS float*)lds3; LAS float* BL = AL + DM; LAS float* CL = BL + DM;
        for (int unit = vcu; unit < M / 64; unit += G) { const int b = unit >> 5; const float* mf = MODF + (size_t)b * NMOD;
#pragma unroll
            for (int c = tid; c < DM; c += NTHR) { AL[c] = mf[2 * DM + c] * g_post_mix[c]; BL[c] = g_pre_mlp[c] * (1.f + mf[4 * DM + c]); CL[c] = mf[3 * DM + c]; }
            __syncthreads();
            const size_t row0 = (size_t)unit * 64 + wid * 8;
#define P5_LOAD(vx, vm, sv, row) do { const f32x4* xr_ = (const f32x4*)(x + (row) * DM) + lane; const v2u* mr_ = (const v2u*)(MIX + (row) * DM) + lane; sv = lane < 32 ? SS1[(row) * 32 + lane] : 0.f; \
                _Pragma("unroll") for (int j = 0; j < 8; ++j) { vx[j] = __builtin_nontemporal_load(&xr_[64 * j]); vm[j] = __builtin_nontemporal_load(&mr_[64 * j]); } } while (0)
#define P5_PROC(vx, vm, sv, row) do { const float rm = rsqrtf(wave_sum(sv) * (1.f / DM) + EPS); v2u* xo = (v2u*)(X1B + (row) * DM) + lane; float ss = 0.f; \
                _Pragma("unroll") for (int j = 0; j < 8; ++j) { const f32x4 a4 = *(const LAS f32x4*)(AL + 4 * (64 * j + lane)); const v2u mw = vm[j]; \
                    const f32x4 mx = {bflo(mw.x), bfhi(mw.x), bflo(mw.y), bfhi(mw.y)}; \
                    vx[j] = vx[j] + a4 * mx * rm; { v2u xw_; xw_.x = pk2(vx[j][0], vx[j][1]); xw_.y = pk2(vx[j][2], vx[j][3]); __builtin_nontemporal_store(xw_, &xo[64 * j]); } ss += (vx[j][0] * vx[j][0] + vx[j][1] * vx[j][1]) + (vx[j][2] * vx[j][2] + vx[j][3] * vx[j][3]); } \
                const float rstd = rsqrtf(wave_sum(ss) * (1.f / DM) + EPS); v2u* o8 = (v2u*)(XN + (row) * DM) + lane; \
                _Pragma("unroll") for (int j = 0; j < 8; ++j) { const f32x4 g4 = *(const LAS f32x4*)(BL + 4 * (64 * j + lane)), s4 = *(const LAS f32x4*)(CL + 4 * (64 * j + lane)); \
                    const f32x4 h = vx[j] * rstd * g4 + s4; v2u w; w.x = pk2(h[0], h[1]); w.y = pk2(h[2], h[3]); o8[64 * j] = w; } } while (0)
            { f32x4 xa[8], xb[8]; v2u ma[8], mb[8]; float sa, sb; P5_LOAD(xa, ma, sa, row0);
#pragma unroll
              for (int i = 0; i < 8; i += 2) { P5_LOAD(xb, mb, sb, row0 + i + 1); P5_PROC(xa, ma, sa, row0 + i); if (i + 2 < 8) P5_LOAD(xa, ma, sa, row0 + i + 2); P5_PROC(xb, mb, sb, row0 + i + 1); } }
#undef P5_LOAD
#undef P5_PROC
            __syncthreads();
        }
    }
    SEAM(5);

    if (IN(6)) {
        pg8::Gemm g{XN, WUP_T, M, DFF, DM}; pg8::StaticOrder S; S.init(M, DFF, G, bx, 2, 4);
        pg8::EpiRelu2 E{U, DFF};
        pg8::gemm_phase<pg8::EpiRelu2, pg8::StaticOrder, false, true>(lds3, g, S, E);
    }
    SEAM(6);

    if (IN(7)) {
        pg8::Gemm g{U, WDN_T, M, DM, DFF, (bx & 7) * 16}; pg8::StaticOrder S; S.init(M, DM, G, bx, 4, 1);
        pg8::EpiBf16SS E{Y, DM, SS2};
        pg8::gemm_phase<pg8::EpiBf16SS, pg8::StaticOrder, true, true>(lds3, g, S, E);
    }
    SEAM(7);

    if (IN(8)) {
        LAS float* GL = (LAS float*)lds3;
        for (int unit = vcu; unit < M / 64; unit += G) { const int b = unit >> 5; const float* mf = MODF + (size_t)b * NMOD;
#pragma unroll
            for (int c = tid; c < DM; c += NTHR) GL[c] = mf[5 * DM + c] * g_post_mlp[c];
            __syncthreads();
            const size_t row0 = (size_t)unit * 64 + wid * 8;
#define P8_LOAD(vx, vy, sv, row) do { const v2u* xr_ = (const v2u*)(X1B + (row) * DM) + lane; const v2u* yr_ = (const v2u*)(Y + (row) * DM) + lane; sv = lane < 32 ? SS2[(row) * 32 + lane] : 0.f; \
                _Pragma("unroll") for (int j = 0; j < 8; ++j) { vx[j] = __builtin_nontemporal_load(&xr_[64 * j]); vy[j] = __builtin_nontemporal_load(&yr_[64 * j]); } } while (0)
#define P8_PROC(vx, vy, sv, row) do { const float ry = rsqrtf(wave_sum(sv) * (1.f / DM) + EPS); f32x4* xo = (f32x4*)(out + (row) * DM) + lane; \
                _Pragma("unroll") for (int j = 0; j < 8; ++j) { const f32x4 g4 = *(const LAS f32x4*)(GL + 4 * (64 * j + lane)); const v2u yw = vy[j]; \
                    const f32x4 yv = {bflo(yw.x), bfhi(yw.x), bflo(yw.y), bfhi(yw.y)}; const v2u xw_ = vx[j]; const f32x4 xv_ = {bflo(xw_.x), bfhi(xw_.x), bflo(xw_.y), bfhi(xw_.y)}; __builtin_nontemporal_store(xv_ + g4 * yv * ry, &xo[64 * j]); } } while (0)
            { v2u xa[8], xb[8]; v2u ya[8], yb[8]; float sa, sb; P8_LOAD(xa, ya, sa, row0);
#pragma unroll
              for (int i = 0; i < 8; i += 2) { P8_LOAD(xb, yb, sb, row0 + i + 1); P8_PROC(xa, ya, sa, row0 + i); if (i + 2 < 8) P8_LOAD(xa, ya, sa, row0 + i + 2); P8_PROC(xb, yb, sb, row0 + i + 1); } }
#undef P8_LOAD
#undef P8_PROC
            __syncthreads();
        }
    }
#undef IN
#undef SEAM
}

extern "C" void kernel_launch(void* const* d_in, const int* in_sizes, int n_in, void* d_out, int out_size, void* d_ws, size_t ws_size, hipStream_t stream) {
    static int grid = 0;
    if (grid == 0) {
        if (n_in != 14 || in_sizes[0] != M * DM || out_size != M * DM || ws_size < WS_END) { fprintf(stderr, "kernel_launch: shape/workspace mismatch (n_in %d, in0 %d, out %d, ws %zu)\n", n_in, n_in > 0 ? in_sizes[0] : -1, out_size, ws_size); grid = -1; return; }
        int dev = 0, cus = 0, per_cu = 0;
        (void)hipGetDevice(&dev); (void)hipDeviceGetAttribute(&cus, hipDeviceAttributeMultiprocessorCount, dev);
        if (hipFuncSetAttribute((const void*)fwd_mega, hipFuncAttributeMaxDynamicSharedMemorySize, LDS_BYTES) != hipSuccess) fprintf(stderr, "kernel_launch: hipFuncSetAttribute failed\n");
        if (hipOccupancyMaxActiveBlocksPerMultiprocessor(&per_cu, (const void*)fwd_mega, NTHR, LDS_BYTES) != hipSuccess || per_cu < 1) { fprintf(stderr, "kernel_launch: occupancy query says %d\n", per_cu); per_cu = 1; }
        (void)hipGetLastError();
        (void)cus; grid = 256;
    }
    if (grid < 0) return;
    if (hipMemsetAsync(d_ws, 0, 65536, stream) != hipSuccess) { fprintf(stderr, "kernel_launch: memset failed\n"); return; }
    Args a{};
    for (int i = 0; i < 14; ++i) a.in[i] = (const float*)d_in[i];
    a.out = (float*)d_out; a.ws = (unsigned char*)d_ws;
    if (MK_N_LAUNCHES == 1) {
        a.ph_lo = 0; a.ph_hi = N_PHASES;
        void* args[] = {&a};
        hipError_t e = hipLaunchCooperativeKernel((const void*)fwd_mega, dim3(grid), dim3(NTHR), args, LDS_BYTES, stream);
        if (e != hipSuccess) fprintf(stderr, "kernel_launch: cooperative launch failed: %s (grid %d)\n", hipGetErrorString(e), grid);
    } else {
        for (int p = 0; p < N_PHASES; ++p) { a.ph_lo = p; a.ph_hi = p + 1; hipLaunchKernelGGL(fwd_mega, dim3(grid), dim3(NTHR), LDS_BYTES, stream, a); }
    }
}
```
